# Optimizing an MI355X kernel written in HIP

```python
import jax, jax.numpy as jnp
from jax import lax
import numpy as np

D_MODEL = 1024
BATCH = 16
SEQ = 256
DEPTH = 4
DEC_BATCH = 4
DEC_SEQ = 4096
PAST_LEN = 256

GRID_W = 64
N_HEADS_A = 4
DK_A = 64
DV_A = 128
QK_W = N_HEADS_A * DK_A
V_W = N_HEADS_A * DV_A
GLA_LOWRANK = 16
GATE_NORMALIZER = 16.0
GLA_CHUNK = 64
SC_W = 512
SC_KERNEL = 3
FN_GROUPS = 4
FN_GW = 128
FN_W = FN_GROUPS * FN_GW
N_BRANCH = 3
D_FF = ((8 * D_MODEL // 3 + 255) // 256) * 256
N_MOD = 6
EPS = 1e-6
IN_SIZES = (QK_W, QK_W, V_W, V_W, GLA_LOWRANK, GLA_LOWRANK, SC_W, SC_W, SC_W, FN_W, N_BRANCH * D_MODEL)
P_IN = sum(IN_SIZES)

kernel_name = 'hybrid_gla_conv_fourier_dit_step'


def rms_norm(x, g):
    xf = x.astype(jnp.float32)
    y = xf * lax.rsqrt(jnp.mean(xf * xf, axis=-1, keepdims=True) + EPS)
    return (y * g.astype(jnp.float32)).astype(x.dtype)


def gla_scan(q, k, v, log_a, s0):
    bsz, nh, L, _ = q.shape
    n = L // GLA_CHUNK

    def blk(t):
        return t.reshape(bsz, nh, n, GLA_CHUNK, t.shape[-1])

    q, k, v, log_a = blk(q), blk(k), blk(v), blk(log_a)
    b = jnp.cumsum(log_a, axis=3)
    b_last = b[:, :, :, -1:, :]
    q_in = q * jnp.exp(b)
    k_in = k * jnp.exp(-b)
    k_out = k * jnp.exp(b_last - b)
    mask = jnp.tril(jnp.ones((GLA_CHUNK, GLA_CHUNK), dtype=bool))
    att = jnp.where(mask, jnp.einsum('bhntd,bhnsd->bhnts', q_in, k_in), 0.0)
    o_intra = jnp.einsum('bhnts,bhnse->bhnte', att, v)
    u = jnp.einsum('bhnsd,bhnse->bhnde', k_out, v)
    g = jnp.exp(b_last[:, :, :, 0, :])

    def step(s, xs):
        g_n, u_n = xs
        return g_n[..., None] * s + u_n, s

    s_final, s_start = lax.scan(step, s0, (jnp.moveaxis(g, 2, 0), jnp.moveaxis(u, 2, 0)))
    s_start = jnp.moveaxis(s_start, 0, 2)
    o_inter = jnp.einsum('bhntd,bhnde->bhnte', q_in, s_start)
    return (o_intra + o_inter).reshape(bsz, nh, L, v.shape[-1]), s_final


def gla_bidir(q, k, v, la_f, la_b, s0_f, s0_b):
    o_f, s_f = gla_scan(q, k, v, la_f, s0_f)
    flip = lambda t: jnp.flip(t, axis=2)
    o_b, s_b = gla_scan(flip(q), flip(k), flip(v), flip(la_b), s0_b)
    return o_f + flip(o_b), s_f, s_b


def dwconv3(u, w, axis):
    n = u.shape[axis]
    pad = [(0, 0)] * u.ndim
    pad[axis] = (1, 1)
    up = jnp.pad(u, pad)
    return sum(w[i] * lax.slice_in_dim(up, i, i + n, axis=axis) for i in range(SC_KERNEL))


def token_mixing(h, s0_f, s0_b, rows, p):
    bsz, L, _ = h.shape
    f32 = jnp.float32
    pts = np.cumsum(IN_SIZES)[:-1].tolist()
    q, k, v, og, gkf, gkb, sb, sc, sx, fx, mg = jnp.split(h @ p['w_in'], pts, axis=-1)

    def heads(t):
        return t.reshape(bsz, L, N_HEADS_A, -1).transpose(0, 2, 1, 3).astype(f32)

    la_f = jax.nn.log_sigmoid((gkf @ p['w_gk_f'] + p['b_gk_f']).astype(f32)) / GATE_NORMALIZER
    la_b = jax.nn.log_sigmoid((gkb @ p['w_gk_b'] + p['b_gk_b']).astype(f32)) / GATE_NORMALIZER
    o, s_f, s_b = gla_bidir(heads(q) * DK_A ** -0.5, heads(k), heads(v), heads(la_f), heads(la_b),
                            s0_f.astype(f32), s0_b.astype(f32))
    o = o.transpose(0, 2, 1, 3)
    o = o * lax.rsqrt(jnp.mean(o * o, axis=-1, keepdims=True) + EPS) * p['gla_norm'].astype(f32)
    y_a = (o.reshape(bsz, L, V_W).astype(h.dtype) * jax.nn.silu(og)) @ p['w_a_out']

    u = sc * sx
    if rows is None:
        u = dwconv3(u, p['conv_w'], axis=1)
    else:
        u = dwconv3(u.reshape(bsz, rows, GRID_W, SC_W), p['conv_w'], axis=2).reshape(bsz, L, SC_W)
    y_b = (sb * u) @ p['w_b_out']

    fr = jnp.fft.fft2(fx.reshape(bsz, L, FN_GROUPS, FN_GW).astype(f32), axes=(1, 3), norm='ortho').real
    y_c = fr.reshape(bsz, L, FN_W).astype(h.dtype) @ p['w_c_out']

    g = jax.nn.sigmoid(mg.reshape(bsz, L, N_BRANCH, D_MODEL))
    y = g[:, :, 0] * y_a + g[:, :, 1] * y_b + g[:, :, 2] * y_c
    return y @ p['w_o'], s_f, s_b


def swiglu(h, w_up, w_down):
    gate, up = jnp.split(h @ w_up, 2, axis=-1)
    return (jax.nn.silu(gate) * up) @ w_down


def trunk_layer(x, cond, s0_f, s0_b, rows, p):
    m = jax.nn.silu(cond) @ p['w_ada'] + p['b_ada']
    sh1, sc1, g1, sh2, sc2, g2 = jnp.split(m[:, None, :], N_MOD, axis=-1)
    h = rms_norm(x, p['norm1']) * (1 + sc1) + sh1
    mix, s_f, s_b = token_mixing(h, s0_f, s0_b, rows, p)
    x = x + g1 * mix
    h = rms_norm(x, p['norm2']) * (1 + sc2) + sh2
    x = x + g2 * swiglu(h, p['w_up'], p['w_down'])
    return x, s_f, s_b


def setup_inputs(seed: int = 0) -> dict:
    key = jax.random.key(seed)
    ks = jax.random.split(key, 23)
    f = jnp.float32
    nrm = jax.random.normal

    def w(k, shape, fan_in):
        return nrm(k, shape, f) * fan_in ** -0.5

    def gain(k, shape):
        return 1.0 + 0.02 * nrm(k, shape, f)

    return {
        'x_prompt': nrm(ks[0], (BATCH, SEQ, D_MODEL), f),
        'x_sample': nrm(ks[1], (DEC_BATCH, DEC_SEQ, D_MODEL), f),
        'state_gla': nrm(ks[2], (DEC_BATCH, DEPTH, 2, N_HEADS_A, DK_A, DV_A), f),
        'c': nrm(ks[3], (DEC_BATCH, D_MODEL), f),
        'c_ctx': nrm(ks[4], (D_MODEL,), f),
        'w_ada': w(ks[5], (DEPTH, D_MODEL, N_MOD * D_MODEL), D_MODEL),
        'b_ada': 0.02 * nrm(ks[6], (DEPTH, N_MOD * D_MODEL), f),
        'norm1': gain(ks[7], (DEPTH, D_MODEL)),
        'norm2': gain(ks[8], (DEPTH, D_MODEL)),
        'w_in': w(ks[9], (DEPTH, D_MODEL, P_IN), D_MODEL),
        'w_gk_f': w(ks[10], (DEPTH, GLA_LOWRANK, QK_W), GLA_LOWRANK),
        'b_gk_f': 0.02 * nrm(ks[11], (DEPTH, QK_W), f),
        'w_gk_b': w(ks[12], (DEPTH, GLA_LOWRANK, QK_W), GLA_LOWRANK),
        'b_gk_b': 0.02 * nrm(ks[13], (DEPTH, QK_W), f),
        'gla_norm': gain(ks[14], (DEPTH, DV_A)),
        'w_a_out': w(ks[15], (DEPTH, V_W, D_MODEL), V_W),
        'conv_w': w(ks[16], (DEPTH, SC_KERNEL, SC_W), SC_KERNEL),
        'w_b_out': w(ks[17], (DEPTH, SC_W, D_MODEL), SC_W),
        'w_c_out': w(ks[18], (DEPTH, FN_W, D_MODEL), FN_W),
        'w_o': w(ks[19], (DEPTH, D_MODEL, D_MODEL), D_MODEL),
        'w_up': w(ks[20], (DEPTH, D_MODEL, 2 * D_FF), D_MODEL),
        'w_down': w(ks[21], (DEPTH, D_FF, D_MODEL), D_FF),
        'norm_f': gain(ks[22], (D_MODEL,)),
    }


def reference(x_prompt, x_sample, state_gla, c, c_ctx, w_ada, b_ada, norm1, norm2, w_in,
              w_gk_f, b_gk_f, w_gk_b, b_gk_b, gla_norm, w_a_out, conv_w, w_b_out, w_c_out,
              w_o, w_up, w_down, norm_f):
    xp, xs = x_prompt, x_sample
    rows = x_sample.shape[1] // GRID_W
    zero_state = jnp.zeros((x_prompt.shape[0], N_HEADS_A, DK_A, DV_A), jnp.float32)
    cond_ctx = c_ctx[None, :]
    ctx_states = []
    for l in range(DEPTH):
        p = {'w_ada': w_ada[l], 'b_ada': b_ada[l], 'norm1': norm1[l], 'norm2': norm2[l],
             'w_in': w_in[l], 'w_gk_f': w_gk_f[l], 'b_gk_f': b_gk_f[l], 'w_gk_b': w_gk_b[l],
             'b_gk_b': b_gk_b[l], 'gla_norm': gla_norm[l], 'w_a_out': w_a_out[l],
             'conv_w': conv_w[l], 'w_b_out': w_b_out[l], 'w_c_out': w_c_out[l], 'w_o': w_o[l],
             'w_up': w_up[l], 'w_down': w_down[l]}
        xp, s_f, s_b = trunk_layer(xp, cond_ctx, zero_state, zero_state, None, p)
        ctx_states.append(jnp.stack([s_f, s_b], axis=1))
        xs, _, _ = trunk_layer(xs, c, state_gla[:, l, 0], state_gla[:, l, 1], rows, p)
    new_state_gla = jnp.stack(ctx_states, axis=1).astype(x_prompt.dtype)
    y_prompt = rms_norm(xp, norm_f)
    y_sample = rms_norm(xs, norm_f)
    return (y_prompt, y_sample, new_state_gla)
```

```cpp
#include <hip/hip_runtime.h>
#include <hip/hip_cooperative_groups.h>
#include <cstdio>
#include <cstdint>
namespace cg = cooperative_groups;

#define GAS __attribute__((address_space(1)))
#define LAS __attribute__((address_space(3)))
typedef unsigned short bf16_t;
typedef short bf16x8 __attribute__((ext_vector_type(8)));
typedef float f32x4 __attribute__((ext_vector_type(4)));
typedef float f32x2 __attribute__((ext_vector_type(2)));
typedef unsigned u32x4 __attribute__((ext_vector_type(4)));
typedef unsigned u32x2 __attribute__((ext_vector_type(2)));

constexpr int DM = 1024, NCTX = 4096, MT = 20480, PIN = 6688, NMOD = 6144, DFF = 2816, DEPTH = 4;
constexpr int NZ1 = 3072, NZA = 1536, NPT = 1280, NMG = 3072, NCH = 320;
constexpr float EPS = 1e-6f;
constexpr size_t MiB = 1u << 20;
constexpr size_t WS_MODS = 0, WS_T4096 = 512 * 1024, WS_C256 = 1 * MiB, WS_GG = 2 * MiB, WS_GKT = 4 * MiB;
constexpr size_t WS_WIN = 6 * MiB, WS_WPT = 12 * MiB, WS_WMG = 15 * MiB, WS_WABC = 21 * MiB, WS_WO = 24 * MiB, WS_WUP = 26 * MiB, WS_WDN = 37 * MiB;
constexpr size_t WS_H = 43 * MiB, WS_Z1 = 83 * MiB, WS_Z1B = 143 * MiB, WS_SS = 203 * MiB, WS_YBF = 203 * MiB, WS_PT = 243 * MiB, WS_C = 283 * MiB, WS_ZG = 243 * MiB, WS_US = 347 * MiB, WS_R4 = 367 * MiB, WS_XP = 427 * MiB, WS_END = 443 * MiB;
constexpr int LDS_BYTES = 147456, LDS_MISC = 131072 + 64;
constexpr size_t WS_BAR = 3 * MiB, WS_PT2 = 315 * MiB;

typedef __bf16 bf16x2_t __attribute__((ext_vector_type(2)));
__device__ __forceinline__ unsigned cvt_pk_bf16(float lo, float hi) { const f32x2 v = {lo, hi}; const bf16x2_t b = __builtin_convertvector(v, bf16x2_t); return __builtin_bit_cast(unsigned, b); }
__device__ __forceinline__ float bf2f(unsigned short x) { return __uint_as_float(((unsigned)x) << 16); }
__device__ __forceinline__ float bflo(unsigned w) { return __uint_as_float(w << 16); }
__device__ __forceinline__ float bfhi(unsigned w) { return __uint_as_float(w & 0xffff0000u); }
__device__ __forceinline__ float sigmoidf_(float x) { return 1.0f / (1.0f + __expf(-x)); }
__device__ __forceinline__ float siluf_(float x) { return x / (1.0f + __expf(-x)); }
__device__ __forceinline__ float logsigf_(float x) { return fminf(x, 0.0f) - __logf(1.0f + __expf(-fabsf(x))); }
__device__ __forceinline__ float fin_(float v) { return v; }
__device__ __forceinline__ float wave_sum(float v) {
#pragma unroll
    for (int o = 1; o < 64; o <<= 1) v += __shfl_xor(v, o);
    return v;
}

namespace pg8 {
constexpr int BM = 256, BK = 64, HALF = 128, HTB = HALF * BK * 2, STAGE_BYTES = 8 * HTB, NXCD = 8, WGM = 8;
__host__ __device__ __forceinline__ int lds_byte(int r, int c) { const int st = (r >> 4) * 2 + (c >> 5), rr = r & 15, cc = c & 31, ob = rr * 64 + cc * 2; return st * 1024 + (ob ^ (((ob >> 9) & 1) << 5)); }
__host__ __device__ __forceinline__ void stage_rc(int b, int& R, int& C) { const int st = b / 1024, sb = b % 1024, swz = sb ^ (((sb >> 9) & 1) << 5); R = (st >> 1) * 16 + swz / 64; C = (st & 1) * 32 + (swz % 64) / 2; }
__host__ __device__ __forceinline__ int perm32(int rho) { const int n = rho >> 4, i = rho & 15; return 8 * (i >> 2) + 4 * n + (i & 3); }

struct Unit { int pm, pn, koff, ks; };
struct Gemm { const bf16_t* A; const bf16_t* Bt; int M, N, K; int Kl; };

struct StaticOrder {
    int nM, nN, nwg, G, c;
    __device__ void init(int M, int N, int G_, int c_) { nM = M / BM; nN = N / BM; nwg = nM * nN; G = G_; c = c_; }
    __device__ __forceinline__ void map(int L, Unit& u) const {
        int wgid = L; { const int q = nwg / NXCD, r = nwg % NXCD, xcd = wgid % NXCD, off = wgid / NXCD; wgid = (xcd < r ? xcd * (q + 1) : r * (q + 1) + (xcd - r) * q) + off; }
        const int nig = WGM * nN, gid = wgid / nig, fm = gid * WGM, gsz = (nM - fm) < WGM ? (nM - fm) : WGM;
        u.pm = fm + ((wgid % nig) % gsz); u.pn = (wgid % nig) / gsz; u.koff = 0; u.ks = 0;
    }
    __device__ bool next(int i, Unit& u) const {
        const long L = (long)i * G + c; if (L >= nwg) return false;
        map((int)L, u); return true;
    }
};
struct BranchOrder {
    StaticOrder so;
    __device__ void init(int G_, int c_) { so.init(MT, DM, G_, c_); }
    __device__ bool next(int i, Unit& u) const {
        const int T = i / 3, br = i - 3 * T;
        const long L = (long)T * so.G + so.c; if (L >= so.nwg) return false;
        so.map((int)L, u); u.pm += br * (MT / BM); u.pn += br * (DM / BM); return true;
    }
};

struct LatOrder {
    StaticOrder so;
    __device__ void init(int G_, int c_) { so.init(MT - NCTX, DM, G_, c_); }
    __device__ bool next(int i, Unit& u) const { if (!so.next(i, u)) return false; u.pm += NCTX / BM; return true; }
};
struct CtxSplitOrder {
    int G, c, Kl;
    __device__ void init(int G_, int c_, int Kl_) { G = G_; c = c_; Kl = Kl_; }
    __device__ bool next(int i, Unit& u) const {
        int idx;
        if (G >= 128) { if (i > 0) return false; idx = c - (G - 128); if (idx < 0) return false; }
        else { idx = i * G + c; if (idx >= 128) return false; }
        u.ks = idx >> 6; const int t = idx & 63; u.pm = t >> 2; u.pn = t & 3; u.koff = u.ks * Kl; return true;
    }
};

#define PG8_ACC const f32x4 (&acc)[2][2][4][2]
__device__ __forceinline__ u32x4 pack8(f32x4 v0, f32x4 v1) { u32x4 w; w.x = cvt_pk_bf16(v0[0], v0[1]); w.y = cvt_pk_bf16(v0[2], v0[3]); w.z = cvt_pk_bf16(v1[0], v1[1]); w.w = cvt_pk_bf16(v1[2], v1[3]); return w; }

template <int ACT> struct EpiBf16 {
    static constexpr bool PERM = true, AFTER_DRAIN = false;
    bf16_t* O; int ldc; int mode; int R0, L;
    __device__ __forceinline__ void operator()(PG8_ACC, const Unit& u, int wr, int wc, int fr, int fq) const {
        int rb = u.pm * BM, cb = u.pn * BM;
        if (mode == 1) { rb = R0 + (u.pn >> 1) * L + u.pm * BM; cb = (u.pn & 1) * BM; }
        bf16_t* Ob = O;
        if (mode == 2 && u.pn >= 6) { cb -= 6 * BM; Ob = O + (size_t)MT * NZA; }
        const int row0 = rb + wr * 64 + fr, col0 = cb + wc * 32 + 8 * fq;
#pragma unroll
        for (int ai = 0; ai < 2; ++ai)
#pragma unroll
            for (int m = 0; m < 4; ++m) { bf16_t* rowp = Ob + (size_t)(row0 + ai * HALF + m * 16) * ldc + col0;
#pragma unroll
                for (int bj = 0; bj < 2; ++bj) { f32x4 v0 = acc[ai][bj][m][0], v1 = acc[ai][bj][m][1];
                    if (ACT == 2) {
#pragma unroll
                        for (int j = 0; j < 4; ++j) { v0[j] = sigmoidf_(v0[j]); v1[j] = sigmoidf_(v1[j]); } }
                    *(u32x4*)(rowp + bj * HALF) = pack8(v0, v1); } }
    }
};
struct EpiPT {
    static constexpr bool PERM = true, AFTER_DRAIN = false;
    bf16_t* PTc; bf16_t* PTl; bf16_t* GKT;
    __device__ __forceinline__ void operator()(PG8_ACC, const Unit& u, int wr, int wc, int fr, int fq) const {
        const int ct0 = wc * 32 + 8 * fq;
        if (u.pm < 4) {
            const int s = u.pm >> 1, chb = (u.pm & 1) * 256;
            bf16_t* base; size_t rstride;
            if (u.pn < 16) { base = PTc + (size_t)u.pn * 512 * 512 + s * 256; rstride = 512; }
            else { const int q = u.pn - 16; base = PTl + (size_t)(q >> 4) * 512 * 8192 + s * 4096 + (q & 15) * 256; rstride = 8192; }
#pragma unroll
            for (int ai = 0; ai < 2; ++ai)
#pragma unroll
                for (int m = 0; m < 4; ++m) { const int ch = chb + ai * HALF + wr * 64 + m * 16 + fr; bf16_t* rowp = base + (size_t)ch * rstride + ct0;
#pragma unroll
                    for (int bj = 0; bj < 2; ++bj) *(u32x4*)(rowp + bj * HALF) = pack8(acc[ai][bj][m][0], acc[ai][bj][m][1]); }
        } else if (wr == 0) {
#pragma unroll
            for (int m = 0; m < 2; ++m) { const int r = m * 16 + fr; bf16_t* rowp = GKT + (size_t)r * MT + u.pn * BM + ct0;
#pragma unroll
                for (int bj = 0; bj < 2; ++bj) *(u32x4*)(rowp + bj * HALF) = pack8(acc[0][bj][m][0], acc[0][bj][m][1]); }
        }
    }
};
struct EpiBranch {
    static constexpr bool PERM = true, AFTER_DRAIN = false;
    const bf16_t* ZG; float* yacc; bf16_t* ybf;
    __device__ __forceinline__ void operator()(PG8_ACC, const Unit& u, int wr, int wc, int fr, int fq) const {
        const int br = u.pn >> 2, pn = u.pn & 3, pm = u.pm - br * (MT / BM);
        const int row0 = pm * BM + wr * 64 + fr, col0 = pn * BM + wc * 32 + 8 * fq;
#pragma unroll
        for (int ai = 0; ai < 2; ++ai)
#pragma unroll
            for (int mp = 0; mp < 2; ++mp) {
                u32x4 gq[2][2]; f32x4 yin[2][2][2];
#pragma unroll
                for (int mm = 0; mm < 2; ++mm)
#pragma unroll
                    for (int bj = 0; bj < 2; ++bj) { const size_t row = (size_t)(row0 + ai * HALF + (2 * mp + mm) * 16); const int col = col0 + bj * HALF;
                        gq[mm][bj] = *(const u32x4*)(ZG + row * NMG + br * DM + col);
                        if (br != 0) { const float* yp = yacc + row * DM + col; yin[mm][bj][0] = *(const f32x4*)yp; yin[mm][bj][1] = *(const f32x4*)(yp + 4); } }
                asm volatile("" ::: "memory");
#pragma unroll
                for (int mm = 0; mm < 2; ++mm)
#pragma unroll
                    for (int bj = 0; bj < 2; ++bj) { const int m = 2 * mp + mm; const size_t row = (size_t)(row0 + ai * HALF + m * 16); const int col = col0 + bj * HALF;
                        const u32x4 g = gq[mm][bj];
                        f32x4 v0 = acc[ai][bj][m][0], v1 = acc[ai][bj][m][1];
                        v0[0] *= bflo(g.x); v0[1] *= bfhi(g.x); v0[2] *= bflo(g.y); v0[3] *= bfhi(g.y);
                        v1[0] *= bflo(g.z); v1[1] *= bfhi(g.z); v1[2] *= bflo(g.w); v1[3] *= bfhi(g.w);
                        float* yp = yacc + row * DM + col;
                        if (br != 0) { v0 += yin[mm][bj][0]; v1 += yin[mm][bj][1]; }
                        if (br != 2) { *(f32x4*)yp = v0; *(f32x4*)(yp + 4) = v1; }
                        else *(u32x4*)(ybf + row * DM + col) = pack8(v0, v1); }
                asm volatile("" ::: "memory");
            }
    }
};
struct EpiRes {
    static constexpr bool PERM = false, AFTER_DRAIN = false;
    float* x; const float* gate; float rsc;
    __device__ __forceinline__ void operator()(PG8_ACC, const Unit& u, int wr, int wc, int fr, int fq) const {
        const int cond = u.pm < 16 ? 0 : 1 + ((u.pm - 16) >> 4);
        const int col0 = u.pn * BM + wc * 32 + 4 * fq;
        const float* gp = gate + (size_t)cond * NMOD + col0;
        f32x4 gv[2][2];
#pragma unroll
        for (int bj = 0; bj < 2; ++bj)
#pragma unroll
            for (int n = 0; n < 2; ++n) gv[bj][n] = *(const f32x4*)(gp + bj * HALF + n * 16) * rsc;
#pragma unroll
        for (int ai = 0; ai < 2; ++ai) {
            float* rowb = x + (size_t)(u.pm * BM + ai * HALF + wr * 64 + fr) * DM + col0;
            f32x4 xin[4][2][2];
#pragma unroll
            for (int m = 0; m < 4; ++m)
#pragma unroll
                for (int bj = 0; bj < 2; ++bj)
#pragma unroll
                    for (int n = 0; n < 2; ++n) xin[m][bj][n] = *(const f32x4*)(rowb + (size_t)m * 16 * DM + bj * HALF + n * 16);
            asm volatile("" ::: "memory");
#pragma unroll
            for (int m = 0; m < 4; ++m)
#pragma unroll
                for (int bj = 0; bj < 2; ++bj)
#pragma unroll
                    for (int n = 0; n < 2; ++n) *(f32x4*)(rowb + (size_t)m * 16 * DM + bj * HALF + n * 16) = xin[m][bj][n] + gv[bj][n] * acc[ai][bj][m][n];
            asm volatile("" ::: "memory");
        }
    }
};
struct EpiPart {
    static constexpr bool PERM = true, AFTER_DRAIN = false;
    bf16_t* XP; const float* gate;
    __device__ __forceinline__ void operator()(PG8_ACC, const Unit& u, int wr, int wc, int fr, int fq) const {
        const int row0 = u.pm * BM + wr * 64 + fr, col0 = u.pn * BM + wc * 32 + 8 * fq;
        f32x4 gv[2][2];
#pragma unroll
        for (int bj = 0; bj < 2; ++bj)
#pragma unroll
            for (int n = 0; n < 2; ++n) gv[bj][n] = *(const f32x4*)(gate + col0 + bj * HALF + 4 * n);
        bf16_t* base = XP + (size_t)u.ks * NCTX * DM;
#pragma unroll
        for (int ai = 0; ai < 2; ++ai)
#pragma unroll
            for (int m = 0; m < 4; ++m) { bf16_t* rowp = base + (size_t)(row0 + ai * HALF + m * 16) * DM + col0;
#pragma unroll
                for (int bj = 0; bj < 2; ++bj) *(u32x4*)(rowp + bj * HALF) = pack8(acc[ai][bj][m][0] * gv[bj][0], acc[ai][bj][m][1] * gv[bj][1]); }
    }
};
struct EpiSwiglu {
    static constexpr bool PERM = true, AFTER_DRAIN = false;
    bf16_t* FF;
    __device__ __forceinline__ void operator()(PG8_ACC, const Unit& u, int wr, int wc, int fr, int fq) const {
        const int row0 = u.pm * BM + wr * 64 + fr, col0 = u.pn * HALF + wc * 32 + 8 * fq;
#pragma unroll
        for (int ai = 0; ai < 2; ++ai)
#pragma unroll
            for (int m = 0; m < 4; ++m) { f32x4 v0, v1;
#pragma unroll
                for (int j = 0; j < 4; ++j) { v0[j] = siluf_(acc[ai][0][m][0][j]) * acc[ai][1][m][0][j]; v1[j] = siluf_(acc[ai][0][m][1][j]) * acc[ai][1][m][1][j]; }
                *(u32x4*)(FF + (size_t)(row0 + ai * HALF + m * 16) * DFF + col0) = pack8(v0, v1); }
    }
};

template <class Epi, class Sched, bool ALIGN_EPI = false, bool SP2 = false>
__device__ __forceinline__ void gemm_phase(LAS unsigned char* lds, const Gemm g, const Sched& S, const Epi& E) {
    int tid_ = threadIdx.x; asm volatile("" : "+v"(tid_));
    const int tid = tid_, wid = __builtin_amdgcn_readfirstlane(tid >> 6), lane = tid & 63, wr = wid >> 2, wc = wid & 3, fr = lane & 15, fq = lane >> 4;
    const int K = g.K, nt = (g.Kl ? g.Kl : g.K) / BK;
    unsigned voffA[2], voffB[2];
#pragma unroll
    for (int i = 0; i < 2; ++i) { int R, C; stage_rc(tid * 16 + i * 8192, R, C); const int Rb = Epi::PERM ? ((R & ~31) + perm32(R & 31)) : R;
        voffA[i] = (unsigned)(R * K + C) * 2u; voffB[i] = (unsigned)(Rb * K + C) * 2u; }
    const size_t kstep = (size_t)(BK * 2);
    const size_t hstep = (size_t)HALF * K * 2;
    const size_t tstep = 2 * hstep;
    const unsigned ldsw = (unsigned)wid * 1024u;
    const int aoff = lds_byte(wr * 64 + fr, fq * 8), boff = lds_byte(wc * 32 + fr, fq * 8);
#define PG8_SA(b, h) (((b) * 2 + (h)) * HTB)
#define PG8_SB(b, h) ((4 + (b) * 2 + (h)) * HTB)
#define PG8_STAGE(bufoff, gbase, voff) do { _Pragma("unroll") for (int _i = 0; _i < 2; ++_i) \
        __builtin_amdgcn_global_load_lds((const unsigned*)((const char*)(gbase) + (voff)[_i]), (LAS unsigned*)(lds + (bufoff) + ldsw + _i * 8192), 16, 0, 0); } while (0)
#define PG8_LDA(dst, b, h) do { _Pragma("unroll") for (int m = 0; m < 4; ++m) _Pragma("unroll") for (int k = 0; k < 2; ++k) dst[m][k] = *(const LAS bf16x8*)(lds + PG8_SA(b, h) + aoff + m * 2048 + k * 1024); } while (0)
#define PG8_LDB(dst, b, h) do { _Pragma("unroll") for (int n = 0; n < 2; ++n) _Pragma("unroll") for (int k = 0; k < 2; ++k) dst[n][k] = *(const LAS bf16x8*)(lds + PG8_SB(b, h) + boff + n * 2048 + k * 1024); } while (0)
#define PG8_MMA(ai, bj, At, Bt) do { __builtin_amdgcn_s_setprio(1); _Pragma("unroll") for (int m = 0; m < 4; ++m) _Pragma("unroll") for (int n = 0; n < 2; ++n) _Pragma("unroll") for (int k = 0; k < 2; ++k) \
        acc[ai][bj][m][n] = __builtin_amdgcn_mfma_f32_16x16x32_bf16(Bt[n][k], At[m][k], acc[ai][bj][m][n], 0, 0, 0); __builtin_amdgcn_s_setprio(0); } while (0)
#define PG8_WAIT_V(n) asm volatile("s_waitcnt vmcnt(" #n ")" ::: "memory")
#define PG8_WAIT_L(n) asm volatile("s_waitcnt lgkmcnt(" #n ")" ::: "memory")
#define PG8_BAR __builtin_amdgcn_s_barrier()
#define PG8_SCHED __builtin_amdgcn_sched_barrier(0)
    Unit cur, nxt; int ui = 0;
    if (!S.next(0, cur)) return;
    f32x4 acc[2][2][4][2];
#pragma unroll
    for (int a = 0; a < 2; ++a)
#pragma unroll
        for (int b = 0; b < 2; ++b)
#pragma unroll
            for (int m = 0; m < 4; ++m)
#pragma unroll
                for (int n = 0; n < 2; ++n) acc[a][b][m][n] = (f32x4){0.f, 0.f, 0.f, 0.f};
    bf16x8 At[4][2], B0[2][2], B1[2][2];
    const char* cA = (const char*)g.A + (size_t)cur.pm * tstep + (size_t)cur.koff * 2; const char* cB = (const char*)g.Bt + (size_t)cur.pn * tstep + (size_t)cur.koff * 2;
    if constexpr (SP2) {
        PG8_STAGE(PG8_SB(0, 0), cB, voffB); PG8_STAGE(PG8_SB(0, 1), cB + hstep, voffB); PG8_STAGE(PG8_SA(0, 0), cA, voffA); PG8_STAGE(PG8_SA(0, 1), cA + hstep, voffA);
        if (wr == 1) PG8_BAR;
        PG8_WAIT_V(2); PG8_BAR;
        PG8_STAGE(PG8_SB(1, 0), cB + kstep, voffB); PG8_STAGE(PG8_SA(1, 0), cA + kstep, voffA); PG8_STAGE(PG8_SB(1, 1), cB + hstep + kstep, voffB);
        PG8_WAIT_V(6); PG8_BAR;
    } else {
        PG8_STAGE(PG8_SB(0, 0), cB, voffB); PG8_STAGE(PG8_SA(0, 0), cA, voffA); PG8_STAGE(PG8_SB(0, 1), cB + hstep, voffB); PG8_STAGE(PG8_SA(0, 1), cA + hstep, voffA);
        if (wr == 1) PG8_BAR;
        PG8_WAIT_V(4); PG8_BAR;
        PG8_STAGE(PG8_SB(1, 0), cB + kstep, voffB); PG8_STAGE(PG8_SA(1, 0), cA + kstep, voffA); PG8_STAGE(PG8_SB(1, 1), cB + hstep + kstep, voffB);
        PG8_WAIT_V(6); PG8_BAR;
    }
    for (;;) {
        const bool has_next = S.next(ui + 1, nxt);
        const char* nA = has_next ? (const char*)g.A + (size_t)nxt.pm * tstep + (size_t)nxt.koff * 2 : cA; const char* nB = has_next ? (const char*)g.Bt + (size_t)nxt.pn * tstep + (size_t)nxt.koff * 2 : cB;
        for (int t = 0; t < nt; t += 2) {
            const bool last = (t == nt - 2);
            const char* a1 = cA + (size_t)(t + 1) * kstep;
            const char* a2 = last ? nA : cA + (size_t)(t + 2) * kstep; const char* b2 = last ? nB : cB + (size_t)(t + 2) * kstep;
            const char* a3 = a2 + kstep; const char* b3 = b2 + kstep;
            if constexpr (SP2) {
            PG8_LDB(B0, 0, 0); PG8_LDB(B1, 0, 1); PG8_SCHED; PG8_LDA(At, 0, 0); PG8_STAGE(PG8_SA(1, 1), a1 + hstep, voffA);
            PG8_WAIT_V(8); PG8_WAIT_L(0); PG8_BAR; PG8_MMA(0, 0, At, B0); PG8_MMA(0, 1, At, B1); PG8_BAR; PG8_SCHED;
            PG8_LDA(At, 0, 1); PG8_STAGE(PG8_SB(0, 0), b2, voffB); PG8_STAGE(PG8_SB(0, 1), b2 + hstep, voffB); PG8_STAGE(PG8_SA(0, 0), a2, voffA);
            PG8_WAIT_V(8); PG8_WAIT_L(0); PG8_BAR; PG8_MMA(1, 0, At, B0); PG8_MMA(1, 1, At, B1); PG8_BAR; PG8_SCHED;
            PG8_LDB(B0, 1, 0); PG8_LDB(B1, 1, 1); PG8_SCHED; PG8_LDA(At, 1, 0); PG8_STAGE(PG8_SA(0, 1), a2 + hstep, voffA);
            PG8_WAIT_V(8); PG8_WAIT_L(0); PG8_BAR; PG8_MMA(0, 0, At, B0); PG8_MMA(0, 1, At, B1); PG8_BAR; PG8_SCHED;
            PG8_LDA(At, 1, 1); PG8_STAGE(PG8_SB(1, 0), b3, voffB); PG8_STAGE(PG8_SB(1, 1), b3 + hstep, voffB); PG8_STAGE(PG8_SA(1, 0), a3, voffA);
            PG8_WAIT_V(8); PG8_WAIT_L(0); PG8_BAR; PG8_MMA(1, 0, At, B0); PG8_MMA(1, 1, At, B1); PG8_BAR; PG8_SCHED;
            } else {
            PG8_LDB(B0, 0, 0); PG8_SCHED; PG8_LDA(At, 0, 0); PG8_STAGE(PG8_SA(1, 1), a1 + hstep, voffA);
            PG8_WAIT_L(8); PG8_BAR; PG8_WAIT_L(0); PG8_MMA(0, 0, At, B0); PG8_BAR; PG8_SCHED;
            PG8_LDB(B1, 0, 1); PG8_STAGE(PG8_SB(0, 0), b2, voffB);
            PG8_BAR; PG8_WAIT_L(0); PG8_MMA(0, 1, At, B1); PG8_BAR;
            PG8_LDA(At, 0, 1); PG8_STAGE(PG8_SA(0, 0), a2, voffA);
            PG8_BAR; PG8_WAIT_L(0); PG8_MMA(1, 0, At, B0); PG8_BAR; PG8_SCHED;
            PG8_STAGE(PG8_SB(0, 1), b2 + hstep, voffB);
            PG8_WAIT_V(6); PG8_BAR; PG8_MMA(1, 1, At, B1); PG8_BAR;
            PG8_LDB(B0, 1, 0); PG8_SCHED; PG8_LDA(At, 1, 0); PG8_STAGE(PG8_SA(0, 1), a2 + hstep, voffA);
            PG8_WAIT_L(8); PG8_BAR; PG8_WAIT_L(0); PG8_MMA(0, 0, At, B0); PG8_BAR; PG8_SCHED;
            PG8_LDB(B1, 1, 1); PG8_STAGE(PG8_SB(1, 0), b3, voffB);
            PG8_BAR; PG8_WAIT_L(0); PG8_MMA(0, 1, At, B1); PG8_BAR;
            PG8_LDA(At, 1, 1); PG8_STAGE(PG8_SA(1, 0), a3, voffA);
            PG8_BAR; PG8_WAIT_L(0); PG8_MMA(1, 0, At, B0); PG8_BAR; PG8_SCHED;
            PG8_STAGE(PG8_SB(1, 1), b3 + hstep, voffB);
            PG8_WAIT_V(6); PG8_BAR; PG8_MMA(1, 1, At, B1); PG8_BAR;
            }
        }
        if constexpr (ALIGN_EPI) { if (wr == 0) PG8_BAR; }
        E(acc, cur, wr, wc, fr, fq);
        if (!has_next) break;
#pragma unroll
        for (int a = 0; a < 2; ++a)
#pragma unroll
            for (int b = 0; b < 2; ++b)
#pragma unroll
                for (int m = 0; m < 4; ++m)
#pragma unroll
                    for (int n = 0; n < 2; ++n) acc[a][b][m][n] = (f32x4){0.f, 0.f, 0.f, 0.f};
        cur = nxt; cA = nA; cB = nB; ++ui;
        if constexpr (ALIGN_EPI) { if (wr == 1) PG8_BAR; }
    }
    PG8_WAIT_V(0);
    if constexpr (!ALIGN_EPI) { if (wr == 0) PG8_BAR; }
    PG8_BAR;
#undef PG8_SA
#undef PG8_SB
#undef PG8_STAGE
#undef PG8_LDA
#undef PG8_LDB
#undef PG8_MMA
#undef PG8_WAIT_V
#undef PG8_WAIT_L
#undef PG8_BAR
#undef PG8_SCHED
}
}

struct Args { const float* in[23]; float* out; unsigned char* ws; };
enum { I_XP = 0, I_XS, I_STATE, I_C, I_CCTX, I_WADA, I_BADA, I_N1, I_N2, I_WIN, I_WGKF, I_BGKF, I_WGKB, I_BGKB, I_GLAN, I_WA, I_CONVW, I_WB, I_WC, I_WO, I_WUP, I_WDN, I_NF };

struct Ctx {
    LAS unsigned char* lds;
    int tid, lane, wave, G, bid;
    const float* const* in; float* out; unsigned char* ws;
};
__device__ __forceinline__ const Args* args_fresh() { const Args* p = (const Args*)__builtin_amdgcn_kernarg_segment_ptr(); asm volatile("" : "+s"(p)); return p; }
#define REFRESH() do { { int _t = threadIdx.x; asm volatile("" : "+v"(_t)); F.tid = _t; F.lane = _t & 63; F.wave = __builtin_amdgcn_readfirstlane(_t >> 6); } const Args* _a = args_fresh(); F.in = _a->in; F.out = _a->out; F.ws = _a->ws; ws = F.ws; mods = (const float*)(ws + WS_MODS); H = (bf16_t*)(ws + WS_H); Z1 = (bf16_t*)(ws + WS_Z1); mods_l = mods + (size_t)l * 5 * NMOD; } while (0)


__device__ __forceinline__ void p0_mods(const Ctx& F) {
    LAS float* sc = (LAS float*)F.lds;
    LAS float* part = (LAS float*)(F.lds + 20480);
    for (int i = F.tid; i < 5 * DM; i += 512) { const int c = i >> 10, k = i & 1023; const float v = c == 0 ? F.in[I_CCTX][k] : F.in[I_C][(c - 1) * DM + k]; sc[i] = siluf_(v); }
    __syncthreads();
    float* mods = (float*)(F.ws + WS_MODS);
    for (int item = F.bid; item < DEPTH * 96; item += F.G) {
        const int l = item / 96, jb = item % 96;
        const float* w = F.in[I_WADA] + (size_t)l * DM * NMOD + jb * 64 + F.lane;
        float a0 = 0.f, a1 = 0.f, a2 = 0.f, a3 = 0.f, a4 = 0.f;
        const int k0 = F.wave * 128;
#pragma unroll 32
        for (int k = 0; k < 128; ++k) { const float wv = w[(size_t)(k0 + k) * NMOD];
            a0 += sc[k0 + k] * wv; a1 += sc[1024 + k0 + k] * wv; a2 += sc[2048 + k0 + k] * wv; a3 += sc[3072 + k0 + k] * wv; a4 += sc[4096 + k0 + k] * wv; }
        part[(F.wave * 5 + 0) * 64 + F.lane] = a0; part[(F.wave * 5 + 1) * 64 + F.lane] = a1; part[(F.wave * 5 + 2) * 64 + F.lane] = a2;
        part[(F.wave * 5 + 3) * 64 + F.lane] = a3; part[(F.wave * 5 + 4) * 64 + F.lane] = a4;
        __syncthreads();
        if (F.tid < 320) { const int c = F.tid >> 6, j = F.tid & 63; float s = F.in[I_BADA][l * NMOD + jb * 64 + j];
#pragma unroll
            for (int w8 = 0; w8 < 8; ++w8) s += part[(w8 * 5 + c) * 64 + j];
            mods[(size_t)(l * 5 + c) * NMOD + jb * 64 + j] = s; }
        __syncthreads();
    }
    float* T = (float*)(F.ws + WS_T4096);
    for (int j = F.bid * 512 + F.tid; j < 4096; j += F.G * 512) T[j] = cospif((float)j * (1.0f / 2048.0f));
    { u32x4* z = (u32x4*)((bf16_t*)(F.ws + WS_WPT) + (size_t)1056 * DM); const int n16 = 224 * DM * 2 / 16;
      for (int i = F.bid * 512 + F.tid; i < n16; i += F.G * 512) z[i] = (u32x4){0u, 0u, 0u, 0u}; }
}

__device__ __forceinline__ void transpose_item(const float* W, int ldw, int K, int c0, bf16_t* WT, int r0, int k0, LAS float* scr, int lane) {
#pragma unroll 8
    for (int i = 0; i < 32; ++i) { const int kk = 2 * i + (lane >> 5); scr[kk * 33 + (lane & 31)] = W[(size_t)(k0 + kk) * ldw + c0 + (lane & 31)]; }
    asm volatile("s_waitcnt lgkmcnt(0)" ::: "memory");
    const int c = lane & 7;
#pragma unroll
    for (int j = 0; j < 4; ++j) { const int n = (lane >> 3) + 8 * j; const LAS float* s = scr + (8 * c) * 33 + n;
        u32x4 o; o.x = cvt_pk_bf16(s[0 * 33], s[1 * 33]); o.y = cvt_pk_bf16(s[2 * 33], s[3 * 33]); o.z = cvt_pk_bf16(s[4 * 33], s[5 * 33]); o.w = cvt_pk_bf16(s[6 * 33], s[7 * 33]);
        *(u32x4*)(WT + (size_t)(r0 + n) * K + k0 + 8 * c) = o; }
    asm volatile("s_waitcnt lgkmcnt(0)" ::: "memory");
}
__device__ __forceinline__ void p1_convert(const Ctx& F, int l, int part, int cs, int gs) {
    LAS float* scr = (LAS float*)(F.lds + F.wave * 8448);
    const int gw = cs * 8 + F.wave, NGW = gs * 8;
    constexpr int I_IN = 16 * 96, I_GK = 16, I_MG = 16 * 96, I_ABC = 8 * 32, I_O = 16 * 32, I_UP = 16 * 176, I_DN = 44 * 32;
    constexpr int NITEMS = I_IN + I_GK + I_MG + 3 * I_ABC + I_O + I_UP + I_DN;
    const float* win = F.in[I_WIN] + (size_t)l * DM * PIN;
    const int it_lo = part == 2 ? NITEMS - I_DN : 0, it_hi = part == 1 ? NITEMS - I_DN : NITEMS;
    for (int it = it_lo + gw; it < it_hi; it += NGW) {
        int r = it;
        if (r < I_IN) { const int kb = r / 96, nb = r % 96, r0 = nb * 32; transpose_item(win, PIN, DM, r0 < 1536 ? r0 : r0 + 32, (bf16_t*)(F.ws + WS_WIN), r0, kb * 64, scr, F.lane); continue; } r -= I_IN;
        if (r < I_GK) { transpose_item(win, PIN, DM, 1536, (bf16_t*)(F.ws + WS_WPT), 1024, r * 64, scr, F.lane); continue; } r -= I_GK;
        if (r < I_MG) { const int kb = r / 96, nb = r % 96; transpose_item(win, PIN, DM, 3616 + nb * 32, (bf16_t*)(F.ws + WS_WMG), nb * 32, kb * 64, scr, F.lane); continue; } r -= I_MG;
        if (r < 3 * I_ABC) { const int br = r / I_ABC, q = r % I_ABC, kb = q / 32, nb = q % 32; const float* w = F.in[br == 0 ? I_WA : (br == 1 ? I_WB : I_WC)] + (size_t)l * 512 * DM;
            transpose_item(w, DM, 512, nb * 32, (bf16_t*)(F.ws + WS_WABC) + (size_t)br * DM * 512, nb * 32, kb * 64, scr, F.lane); continue; } r -= 3 * I_ABC;
        if (r < I_O) { const int kb = r / 32, nb = r % 32; transpose_item(F.in[I_WO] + (size_t)l * DM * DM, DM, DM, nb * 32, (bf16_t*)(F.ws + WS_WO), nb * 32, kb * 64, scr, F.lane); continue; } r -= I_O;
        if (r < I_UP) { const int kb = r / 176, nb = r % 176, r0 = nb * 32, t = r0 >> 8, w = r0 & 255; const int c0 = w < 128 ? t * 128 + w : DFF + t * 128 + (w - 128);
            transpose_item(F.in[I_WUP] + (size_t)l * DM * 2 * DFF, 2 * DFF, DM, c0, (bf16_t*)(F.ws + WS_WUP), r0, kb * 64, scr, F.lane); continue; } r -= I_UP;
        { const int kb = r / 32, nb = r % 32; transpose_item(F.in[I_WDN] + (size_t)l * DFF * DM, DM, DFF, nb * 32, (bf16_t*)(F.ws + WS_WDN), nb * 32, kb * 64, scr, F.lane); }
    }
}
__device__ __forceinline__ void p1_fold(const Ctx& F, int l, int cs, int gs) {
    LAS float* Wl = (LAS float*)F.lds;
    LAS float* T128 = (LAS float*)(F.lds + 64 * 129 * 4);
    const float* T = (const float*)(F.ws + WS_T4096);
    const float* win = F.in[I_WIN] + (size_t)l * DM * PIN;
    bf16_t* WPT = (bf16_t*)(F.ws + WS_WPT);
    for (int item = cs; item < 256; item += gs) {
        const int g = item >> 6, kb = (item >> 2) & 15, qt = item & 3;
        __syncthreads();
        for (int i = F.tid; i < 64 * 128; i += 512) { const int k = i >> 7, c = i & 127; Wl[k * 129 + c] = win[(size_t)(kb * 64 + k) * PIN + 3104 + g * 128 + c]; }
        if (F.tid < 128) T128[F.tid] = T[F.tid * 32] * 0.08838834764831845f;
        __syncthreads();
        const int k = F.lane;
        for (int mi = 0; mi < 8; ++mi) {
            const int q = qt * 64 + F.wave * 8 + mi, s = q >> 7, m = q & 127;
            float a = 0.f;
#pragma unroll 8
            for (int c = 0; c < 128; ++c) a += Wl[k * 129 + c] * T128[(c * m + s * 96) & 127];
            const unsigned short b = (unsigned short)(cvt_pk_bf16(a, 0.f) & 0xffffu);
            WPT[(size_t)(s * 512 + g * 128 + m) * DM + kb * 64 + k] = b;
        }
    }
    __syncthreads();
}
__device__ __forceinline__ void p1_cgen(const Ctx& F, bool do256, int cs, int gs) {
    LAS float* T = (LAS float*)F.lds;
    const float* Tg = (const float*)(F.ws + WS_T4096);
    __syncthreads();
    for (int i = F.tid; i < 4096; i += 512) T[i] = Tg[i];
    __syncthreads();
    u32x4* C = (u32x4*)(F.ws + WS_C);
    const int nth = gs * 512;
    for (int it = cs * 512 + F.tid; it < 4096 * 512; it += nth) {
        const int n = it >> 9, kp = (it & 511) * 8, s = kp >> 11, k0 = kp & 2047;
        float v[8];
#pragma unroll
        for (int i = 0; i < 8; ++i) { const int k = k0 + i; const int idx = (s && k == 0) ? (n * 2048) : (n * k + s * 1024); v[i] = T[idx & 4095] * (1.0f / 64.0f); }
        u32x4 o; o.x = cvt_pk_bf16(v[0], v[1]); o.y = cvt_pk_bf16(v[2], v[3]); o.z = cvt_pk_bf16(v[4], v[5]); o.w = cvt_pk_bf16(v[6], v[7]);
        C[it] = o;
    }
    if (do256) {
        u32x4* C2 = (u32x4*)(F.ws + WS_C256);
        for (int it = cs * 512 + F.tid; it < 256 * 64; it += nth) {
            const int n = it >> 6, kp = (it & 63) * 8, s = kp >> 8, k0 = kp & 255;
            float v[8];
#pragma unroll
            for (int i = 0; i < 8; ++i) v[i] = T[((((n * (k0 + i)) & 255) << 4) + s * 1024) & 4095] * (1.0f / 16.0f);
            u32x4 o; o.x = cvt_pk_bf16(v[0], v[1]); o.y = cvt_pk_bf16(v[2], v[3]); o.z = cvt_pk_bf16(v[4], v[5]); o.w = cvt_pk_bf16(v[6], v[7]);
            C2[it] = o;
        }
    }
    __syncthreads();
}

struct FoldIn { u32x4 a, lo, s, slo; unsigned short hi, shi, mid; };
__device__ __forceinline__ void fold_load(const bf16_t* PTl, int it, FoldIn& I) {
    const int row = it >> 8, m = it & 255;
    const bf16_t* pc = PTl + (size_t)row * 8192; const bf16_t* ps = pc + 4096;
    I.a = *(const u32x4*)(pc + 8 * m); I.lo = *(const u32x4*)(pc + 8 * (511 - m)); I.s = *(const u32x4*)(ps + 8 * m); I.slo = *(const u32x4*)(ps + 8 * (511 - m));
    I.hi = pc[8 * (512 - m)]; I.shi = ps[8 * (512 - m) - (m == 0 ? 8 : 0)]; I.mid = pc[2048];
}
__device__ __forceinline__ void fold_finish(bf16_t* PT2, int it, const FoldIn& I) {
    const int row = it >> 8, m = it & 255;
    const u32x4 a = I.a, lo = I.lo, s = I.s, slo = I.slo;
    float av[8] = {bflo(a.x), bfhi(a.x), bflo(a.y), bfhi(a.y), bflo(a.z), bfhi(a.z), bflo(a.w), bfhi(a.w)};
    float sv[8] = {bflo(s.x), bfhi(s.x), bflo(s.y), bfhi(s.y), bflo(s.z), bfhi(s.z), bflo(s.w), bfhi(s.w)};
    const float lv[8] = {bflo(lo.x), bfhi(lo.x), bflo(lo.y), bfhi(lo.y), bflo(lo.z), bfhi(lo.z), bflo(lo.w), bfhi(lo.w)};
    const float tv[8] = {bflo(slo.x), bfhi(slo.x), bflo(slo.y), bfhi(slo.y), bflo(slo.z), bfhi(slo.z), bflo(slo.w), bfhi(slo.w)};
    av[0] += (m > 0) ? bf2f(I.hi) : 0.f; sv[0] -= (m > 0) ? bf2f(I.shi) : 0.f;
#pragma unroll
    for (int j = 1; j < 8; ++j) { av[j] += lv[8 - j]; sv[j] -= tv[8 - j]; }
    if (m == 0) sv[0] = bf2f(I.mid);
    u32x4 o1, o2;
    o1.x = cvt_pk_bf16(av[0], av[1]); o1.y = cvt_pk_bf16(av[2], av[3]); o1.z = cvt_pk_bf16(av[4], av[5]); o1.w = cvt_pk_bf16(av[6], av[7]);
    o2.x = cvt_pk_bf16(sv[0], sv[1]); o2.y = cvt_pk_bf16(sv[2], sv[3]); o2.z = cvt_pk_bf16(sv[4], sv[5]); o2.w = cvt_pk_bf16(sv[6], sv[7]);
    *(u32x4*)(PT2 + (size_t)row * 4096 + 8 * m) = o1; *(u32x4*)(PT2 + (size_t)row * 4096 + 2048 + 8 * m) = o2;
}
__device__ __forceinline__ void pt_fold(const Ctx& F) {
    const bf16_t* PTl = (const bf16_t*)(F.ws + WS_PT + 8 * MiB);
    bf16_t* PT2 = (bf16_t*)(F.ws + WS_PT2);
    const int nth = F.G * 512, NI = 2048 * 256;
    int it = F.bid * 512 + F.tid;
    for (; it + nth < NI; it += 2 * nth) {
        FoldIn A, B; fold_load(PTl, it, A); fold_load(PTl, it + nth, B);
        fold_finish(PT2, it, A); fold_finish(PT2, it + nth, B);
    }
    if (it < NI) { FoldIn A; fold_load(PTl, it, A); fold_finish(PT2, it, A); }
}
__device__ __forceinline__ void norm_pass(const Ctx& F, int mode, const float* nw, const float* mods_l, int shoff, int scoff, bool addp) {
    const int gw = F.bid * 8 + F.wave, NGW = F.G * 8;
    bf16_t* H = (bf16_t*)(F.ws + WS_H);
    f32x4 wv[4];
#pragma unroll
    for (int j = 0; j < 4; ++j) wv[j] = *(const f32x4*)(nw + 4 * F.lane + 256 * j);
    constexpr int NR = 5;
    for (int r0 = gw; r0 < MT; r0 += NR * NGW) {
        f32x4 v[NR][4]; float s[NR]; u32x4 pq[NR][4];
        const bf16_t* XP = (const bf16_t*)(F.ws + WS_XP);
#pragma unroll
        for (int q = 0; q < NR; ++q) s[q] = 0.f;
#pragma unroll
        for (int q = 0; q < NR; ++q) { const int r = r0 + q * NGW;
            if (r < MT) {
                const float* src = (mode == 0) ? (r < NCTX ? F.in[I_XP] + (size_t)r * DM : F.in[I_XS] + (size_t)(r - NCTX) * DM) : F.out + (size_t)r * DM;
#pragma unroll
                for (int j = 0; j < 4; ++j) v[q][j] = *(const f32x4*)(src + 4 * F.lane + 256 * j);
                if (addp && r < NCTX) {
#pragma unroll
                    for (int j = 0; j < 4; ++j) { const u32x2 a = *(const u32x2*)(XP + (size_t)r * DM + 4 * F.lane + 256 * j), b = *(const u32x2*)(XP + (size_t)(NCTX + r) * DM + 4 * F.lane + 256 * j); pq[q][j] = (u32x4){a.x, a.y, b.x, b.y}; }
                }
            } }
#pragma unroll
        for (int q = 0; q < NR; ++q) { const int r = r0 + q * NGW;
            if (r < MT) {
                if (addp && r < NCTX) {
#pragma unroll
                    for (int j = 0; j < 4; ++j) { const u32x4 p = pq[q][j];
                        v[q][j].x += bflo(p.x) + bflo(p.z); v[q][j].y += bfhi(p.x) + bfhi(p.z); v[q][j].z += bflo(p.y) + bflo(p.w); v[q][j].w += bfhi(p.y) + bfhi(p.w);
                        if (mode != 2) *(f32x4*)(F.out + (size_t)r * DM + 4 * F.lane + 256 * j) = v[q][j]; }
                }
#pragma unroll
                for (int j = 0; j < 4; ++j) s[q] += (v[q][j].x * v[q][j].x + v[q][j].y * v[q][j].y) + (v[q][j].z * v[q][j].z + v[q][j].w * v[q][j].w);
                const float rstd = rsqrtf(wave_sum(s[q]) * (1.0f / DM) + EPS);
                if (mode == 2) {
#pragma unroll
                    for (int j = 0; j < 4; ++j) { f32x4 o = v[q][j] * rstd * wv[j]; o[0] = fin_(o[0]); o[1] = fin_(o[1]); o[2] = fin_(o[2]); o[3] = fin_(o[3]); *(f32x4*)(F.out + (size_t)r * DM + 4 * F.lane + 256 * j) = o; }
                } else {
                    if (mode == 0) {
#pragma unroll
                        for (int j = 0; j < 4; ++j) *(f32x4*)(F.out + (size_t)r * DM + 4 * F.lane + 256 * j) = v[q][j];
                    }
                    const int cond = r < NCTX ? 0 : 1 + ((r - NCTX) >> 12);
                    const float* mp = mods_l + (size_t)cond * NMOD;
#pragma unroll
                    for (int j = 0; j < 4; ++j) {
                        const f32x4 sh = *(const f32x4*)(mp + shoff + 4 * F.lane + 256 * j), scv = *(const f32x4*)(mp + scoff + 4 * F.lane + 256 * j);
                        const f32x4 o = v[q][j] * rstd * wv[j] * (scv + 1.0f) + sh;
                        u32x2 w; w.x = cvt_pk_bf16(o[0], o[1]); w.y = cvt_pk_bf16(o[2], o[3]);
                        *(u32x2*)(H + (size_t)r * DM + 4 * F.lane + 256 * j) = w;
                    }
                }
            } }
    }
}

struct GkW { float wf[16], wb[16], bf, bb; };
__device__ __forceinline__ void gla_load_w(const Ctx& F, int l, int h, GkW& W) {
    const int d = F.lane;
    const float* wgf = F.in[I_WGKF] + (size_t)l * 16 * 256 + h * 64 + d; const float* wgb = F.in[I_WGKB] + (size_t)l * 16 * 256 + h * 64 + d;
#pragma unroll
    for (int r = 0; r < 16; ++r) { W.wf[r] = wgf[r * 256]; W.wb[r] = wgb[r * 256]; }
    W.bf = F.in[I_BGKF][l * 256 + h * 64 + d]; W.bb = F.in[I_BGKB][l * 256 + h * 64 + d];
}
__device__ __forceinline__ void gla_decay(const Ctx& F, const GkW& W, LAS float* gk, LAS float* seg, float (&bF)[8], float (&bB)[8], float& totF, float& totB) {
    const int d = F.lane, w = F.wave;
#pragma unroll
    for (int i = 0; i < 8; ++i) { bF[i] = W.bf; bB[i] = W.bb; }
#pragma unroll
    for (int r = 0; r < 16; ++r) {
        const float wf = W.wf[r], wb = W.wb[r];
        const f32x4 f0 = *(const LAS f32x4*)(gk + r * 64 + 8 * w), f1 = *(const LAS f32x4*)(gk + r * 64 + 8 * w + 4);
        const f32x4 g0 = *(const LAS f32x4*)(gk + (16 + r) * 64 + 8 * w), g1 = *(const LAS f32x4*)(gk + (16 + r) * 64 + 8 * w + 4);
#pragma unroll
        for (int j = 0; j < 4; ++j) { bF[j] += f0[j] * wf; bF[4 + j] += f1[j] * wf; bB[j] += g0[j] * wb; bB[4 + j] += g1[j] * wb; }
        if ((r & 3) == 3) asm volatile("" ::: "memory");
    }
#pragma unroll
    for (int i = 0; i < 8; ++i) { bF[i] = logsigf_(bF[i]) * (1.0f / 16.0f); bB[i] = logsigf_(bB[i]) * (1.0f / 16.0f); }
#pragma unroll
    for (int i = 1; i < 8; ++i) bF[i] += bF[i - 1];
#pragma unroll
    for (int i = 6; i >= 0; --i) bB[i] += bB[i + 1];
    seg[w * 64 + d] = bF[7]; seg[(8 + w) * 64 + d] = bB[0];
    __syncthreads();
    float offF = 0.f, offB = 0.f; totF = 0.f; totB = 0.f;
#pragma unroll
    for (int w2 = 0; w2 < 8; ++w2) { const float sf = seg[w2 * 64 + d], sb = seg[(8 + w2) * 64 + d]; totF += sf; totB += sb; if (w2 < w) offF += sf; if (w2 > w) offB += sb; }
#pragma unroll
    for (int i = 0; i < 8; ++i) { bF[i] += offF; bB[i] += offB; }
}
__device__ __forceinline__ u32x2 gla_load_gk(const Ctx& F, int row0) {
    const bf16_t* GKT = (const bf16_t*)(F.ws + WS_GKT);
    const int idx = F.tid * 4, r = idx >> 6, t = idx & 63;
    return *(const u32x2*)(GKT + (size_t)r * MT + row0 + t);
}
__device__ __forceinline__ void gla_store_gk(const Ctx& F, u32x2 w, LAS float* gk) {
    const int idx = F.tid * 4;
    gk[idx] = bflo(w.x); gk[idx + 1] = bfhi(w.x); gk[idx + 2] = bflo(w.y); gk[idx + 3] = bfhi(w.y);
}
__device__ __forceinline__ void gla_stage_vt(const Ctx& F, int row0, int h, LAS bf16_t* VT) {
    const bf16_t* Z1 = (const bf16_t*)(F.ws + WS_Z1);
#pragma unroll
    for (int rep = 0; rep < 2; ++rep) { const int e = F.tid & 127, ts = (F.tid >> 7) + 4 * rep;
        unsigned short v[8];
#pragma unroll
        for (int i = 0; i < 8; ++i) v[i] = Z1[(size_t)(row0 + 8 * ts + i) * NZA + 512 + h * 128 + e];
        u32x4 o; o.x = v[0] | ((unsigned)v[1] << 16); o.y = v[2] | ((unsigned)v[3] << 16); o.z = v[4] | ((unsigned)v[5] << 16); o.w = v[6] | ((unsigned)v[7] << 16);
        *(LAS u32x4*)(VT + e * 72 + 8 * ts) = o; }
}
__device__ __forceinline__ void gla_pass1(const Ctx& F, int l, int item, const GkW& W) {
    const int h = item & 3, ci = item >> 2, row0 = ci * 64, w = F.wave, d = F.lane;
    LAS float* gk = (LAS float*)F.lds; LAS float* seg = (LAS float*)(F.lds + 8192);
    LAS bf16_t* KoF = (LAS bf16_t*)(F.lds + 12288); LAS bf16_t* KoB = (LAS bf16_t*)(F.lds + 21504); LAS bf16_t* VT = (LAS bf16_t*)(F.lds + 30720);
    const bf16_t* Z1 = (const bf16_t*)(F.ws + WS_Z1);
    const u32x2 gkraw = gla_load_gk(F, row0);
    unsigned short kraw[8], vraw[2][8];
#pragma unroll
    for (int i = 0; i < 8; ++i) kraw[i] = Z1[(size_t)(row0 + 8 * w + i) * NZA + 256 + h * 64 + d];
#pragma unroll
    for (int rep = 0; rep < 2; ++rep) { const int e = F.tid & 127, ts = (F.tid >> 7) + 4 * rep;
#pragma unroll
        for (int i = 0; i < 8; ++i) vraw[rep][i] = Z1[(size_t)(row0 + 8 * ts + i) * NZA + 512 + h * 128 + e]; }
    __syncthreads();
    gla_store_gk(F, gkraw, gk);
    __syncthreads();
    float bF[8], bB[8], totF, totB;
    gla_decay(F, W, gk, seg, bF, bB, totF, totB);
    {
        float kf[8], kb[8];
#pragma unroll
        for (int i = 0; i < 8; ++i) { const float kv = bf2f(kraw[i]); kf[i] = kv * __expf(totF - bF[i]); kb[i] = kv * __expf(totB - bB[i]); }
        u32x4 o; o.x = cvt_pk_bf16(kf[0], kf[1]); o.y = cvt_pk_bf16(kf[2], kf[3]); o.z = cvt_pk_bf16(kf[4], kf[5]); o.w = cvt_pk_bf16(kf[6], kf[7]);
        *(LAS u32x4*)(KoF + d * 72 + 8 * w) = o;
        o.x = cvt_pk_bf16(kb[0], kb[1]); o.y = cvt_pk_bf16(kb[2], kb[3]); o.z = cvt_pk_bf16(kb[4], kb[5]); o.w = cvt_pk_bf16(kb[6], kb[7]);
        *(LAS u32x4*)(KoB + d * 72 + 8 * w) = o;
    }
#pragma unroll
    for (int rep = 0; rep < 2; ++rep) { const int e = F.tid & 127, ts = (F.tid >> 7) + 4 * rep;
        u32x4 o; o.x = vraw[rep][0] | ((unsigned)vraw[rep][1] << 16); o.y = vraw[rep][2] | ((unsigned)vraw[rep][3] << 16); o.z = vraw[rep][4] | ((unsigned)vraw[rep][5] << 16); o.w = vraw[rep][6] | ((unsigned)vraw[rep][7] << 16);
        *(LAS u32x4*)(VT + e * 72 + 8 * ts) = o; }
    float* GG = (float*)(F.ws + WS_GG);
    if (w == 0) { GG[(size_t)((0 * NCH + ci) * 4 + h) * 64 + d] = __expf(totF); GG[(size_t)((1 * NCH + ci) * 4 + h) * 64 + d] = __expf(totB); }
    __syncthreads();
    const int r = F.lane & 15, quad = F.lane >> 4;
    bf16_t* US = (bf16_t*)(F.ws + WS_US);
#pragma unroll
    for (int dir = 0; dir < 2; ++dir) {
        const LAS bf16_t* Ko = dir ? KoB : KoF;
        bf16_t* ub = US + (size_t)((dir * NCH + ci) * 4 + h) * 8192;
        bf16x8 bv[2];
#pragma unroll
        for (int ks = 0; ks < 2; ++ks) bv[ks] = *(const LAS bf16x8*)(VT + (16 * w + r) * 72 + ks * 32 + quad * 8);
#pragma unroll
        for (int mt = 0; mt < 4; ++mt) {
            f32x4 acc = {0.f, 0.f, 0.f, 0.f};
#pragma unroll
            for (int ks = 0; ks < 2; ++ks) { const bf16x8 a = *(const LAS bf16x8*)(Ko + (16 * mt + r) * 72 + ks * 32 + quad * 8); acc = __builtin_amdgcn_mfma_f32_16x16x32_bf16(a, bv[ks], acc, 0, 0, 0); }
            u32x2 o; o.x = cvt_pk_bf16(acc[0], acc[1]); o.y = cvt_pk_bf16(acc[2], acc[3]);
            *(u32x2*)(ub + (16 * w + r) * 64 + 16 * mt + quad * 4) = o;
        }
    }
}
__device__ __forceinline__ void gla_scan(const Ctx& F, int l) {
    const bf16_t* US = (const bf16_t*)(F.ws + WS_US); bf16_t* SS = (bf16_t*)(F.ws + WS_SS); const float* GG = (const float*)(F.ws + WS_GG);
    float* ostate = F.out + (size_t)MT * DM;
    const int nth = F.G * 512;
    for (int wid = F.bid * 512 + F.tid; wid < 131072 + 524288; wid += nth) {
        const bool lat = wid < 131072; const int q = lat ? wid : wid - 131072;
        const int p = q & 4095, chain = q >> 12, dir = chain & 1, h = (chain >> 1) & 3, b = chain >> 3;
        const int e = p >> 5, d = (p & 31) * 2;
        const int N = lat ? 64 : 4, cbase = lat ? 64 + b * 64 : b * 4;
        const size_t sidx = ((size_t)((((b * 4 + l) * 2 + dir) * 4 + h) * 64 + d)) * 128 + e;
        float s0 = 0.f, s1 = 0.f;
        if (lat) { s0 = F.in[I_STATE][sidx]; s1 = F.in[I_STATE][sidx + 128]; }
#define SCAN_BATCH(NB) do { unsigned uu[NB]; f32x2 gg[NB]; \
            _Pragma("unroll") for (int i = 0; i < NB; ++i) { const int n = dir ? (N - 1 - (n0 + i)) : (n0 + i); const size_t cb = (size_t)((dir * NCH + cbase + n) * 4 + h); \
                uu[i] = *(const unsigned*)(US + cb * 8192 + e * 64 + d); gg[i] = *(const f32x2*)(GG + cb * 64 + d); } \
            _Pragma("unroll") for (int i = 0; i < NB; ++i) { const int n = dir ? (N - 1 - (n0 + i)) : (n0 + i); const size_t cb = (size_t)((dir * NCH + cbase + n) * 4 + h); \
                *(unsigned*)(SS + cb * 8192 + e * 64 + d) = cvt_pk_bf16(s0, s1); \
                s0 = gg[i].x * s0 + bflo(uu[i]); s1 = gg[i].y * s1 + bfhi(uu[i]); } } while (0)
        if (lat) { for (int n0 = 0; n0 < 64; n0 += 8) SCAN_BATCH(8); }
        else { const int n0 = 0; SCAN_BATCH(4); }
#undef SCAN_BATCH
        if (!lat) { ostate[sidx] = fin_(s0); ostate[sidx + 128] = fin_(s1); }
    }
}
__device__ __forceinline__ void gla_pass3(const Ctx& F, int l, int item, const GkW& W) {
    const int h = item & 3, ci = item >> 2, row0 = ci * 64, w = F.wave, d = F.lane;
    LAS float* gk = (LAS float*)F.lds; LAS float* seg = (LAS float*)(F.lds + 8192);
    LAS bf16_t* QF = (LAS bf16_t*)(F.lds + 12288); LAS bf16_t* QB = (LAS bf16_t*)(F.lds + 21504); LAS bf16_t* KF = (LAS bf16_t*)(F.lds + 30720); LAS bf16_t* KB = (LAS bf16_t*)(F.lds + 39936);
    LAS bf16_t* VT = (LAS bf16_t*)(F.lds + 49152); LAS bf16_t* PF = (LAS bf16_t*)(F.lds + 67584); LAS bf16_t* PB = (LAS bf16_t*)(F.lds + 76800); LAS float* O = (LAS float*)(F.lds + 86016);
    const bf16_t* Z1 = (const bf16_t*)(F.ws + WS_Z1);
    const u32x2 gkraw = gla_load_gk(F, row0);
    unsigned short qraw[8], kraw[8], vraw[2][8];
#pragma unroll
    for (int i = 0; i < 8; ++i) { const bf16_t* zr = Z1 + (size_t)(row0 + 8 * w + i) * NZA + h * 64 + d; qraw[i] = zr[0]; kraw[i] = zr[256]; }
#pragma unroll
    for (int rep = 0; rep < 2; ++rep) { const int e = F.tid & 127, ts = (F.tid >> 7) + 4 * rep;
#pragma unroll
        for (int i = 0; i < 8; ++i) vraw[rep][i] = Z1[(size_t)(row0 + 8 * ts + i) * NZA + 512 + h * 128 + e]; }
    const bf16_t* ogp = Z1 + (size_t)(row0 + (F.tid >> 3)) * NZA + 1024 + h * 128 + (F.tid & 7) * 16;
    const u32x4 og0 = *(const u32x4*)ogp, og1 = *(const u32x4*)(ogp + 8);
    bf16x8 sfr[2][2][4];
    {
        const bf16_t* SSg = (const bf16_t*)(F.ws + WS_SS);
        const int r_ = F.lane & 15, quad_ = F.lane >> 4, eh_ = w >> 2;
#pragma unroll
        for (int dir = 0; dir < 2; ++dir) { const bf16_t* Sb = SSg + (size_t)((dir * NCH + ci) * 4 + h) * 8192;
#pragma unroll
            for (int ks = 0; ks < 2; ++ks)
#pragma unroll
                for (int nt = 0; nt < 4; ++nt) sfr[dir][ks][nt] = *(const bf16x8*)(Sb + (16 * (eh_ * 4 + nt) + r_) * 64 + ks * 32 + quad_ * 8); }
    }
    __syncthreads();
    gla_store_gk(F, gkraw, gk);
    __syncthreads();
    float bF[8], bB[8], totF, totB;
    gla_decay(F, W, gk, seg, bF, bB, totF, totB);
#pragma unroll
    for (int i = 0; i < 8; ++i) { const int t = 8 * w + i;
        const float qv = bf2f(qraw[i]) * 0.125f, kv = bf2f(kraw[i]); const float ef = __expf(bF[i]), eb = __expf(bB[i]);
        const unsigned a = cvt_pk_bf16(qv * ef, kv / ef), b2 = cvt_pk_bf16(qv * eb, kv / eb);
        QF[t * 72 + d] = (unsigned short)(a & 0xffffu); KF[t * 72 + d] = (unsigned short)(a >> 16); QB[t * 72 + d] = (unsigned short)(b2 & 0xffffu); KB[t * 72 + d] = (unsigned short)(b2 >> 16); }
#pragma unroll
    for (int rep = 0; rep < 2; ++rep) { const int e = F.tid & 127, ts = (F.tid >> 7) + 4 * rep;
        u32x4 o; o.x = vraw[rep][0] | ((unsigned)vraw[rep][1] << 16); o.y = vraw[rep][2] | ((unsigned)vraw[rep][3] << 16); o.z = vraw[rep][4] | ((unsigned)vraw[rep][5] << 16); o.w = vraw[rep][6] | ((unsigned)vraw[rep][7] << 16);
        *(LAS u32x4*)(VT + e * 72 + 8 * ts) = o; }
    __syncthreads();
    const int r = F.lane & 15, quad = F.lane >> 4;
    {
        const int dir = w >> 2, mt = w & 3; const LAS bf16_t* Q = dir ? QB : QF; const LAS bf16_t* Kk = dir ? KB : KF; LAS bf16_t* P = dir ? PB : PF;
        f32x4 acc[4];
#pragma unroll
        for (int nt = 0; nt < 4; ++nt) acc[nt] = (f32x4){0.f, 0.f, 0.f, 0.f};
#pragma unroll
        for (int ks = 0; ks < 2; ++ks) { const bf16x8 a = *(const LAS bf16x8*)(Q + (16 * mt + r) * 72 + ks * 32 + quad * 8);
#pragma unroll
            for (int nt = 0; nt < 4; ++nt) { const bf16x8 b = *(const LAS bf16x8*)(Kk + (16 * nt + r) * 72 + ks * 32 + quad * 8); acc[nt] = __builtin_amdgcn_mfma_f32_16x16x32_bf16(a, b, acc[nt], 0, 0, 0); } }
#pragma unroll
        for (int nt = 0; nt < 4; ++nt)
#pragma unroll
            for (int j = 0; j < 4; ++j) { const int t = 16 * mt + quad * 4 + j, s = 16 * nt + r; const bool keep = dir ? (s >= t) : (s <= t);
                P[t * 72 + s] = (unsigned short)(cvt_pk_bf16(keep ? acc[nt][j] : 0.f, 0.f) & 0xffffu); }
    }
    __syncthreads();
    {
        const int mt = w & 3, eh = w >> 2;
        const bf16_t* US = (const bf16_t*)(F.ws + WS_SS);
        f32x4 acc[4];
#pragma unroll
        for (int nt = 0; nt < 4; ++nt) acc[nt] = (f32x4){0.f, 0.f, 0.f, 0.f};
#pragma unroll
        for (int dir = 0; dir < 2; ++dir) {
            const LAS bf16_t* P = dir ? PB : PF; const LAS bf16_t* Q = dir ? QB : QF;
            const bf16_t* Sb = US + (size_t)((dir * NCH + ci) * 4 + h) * 8192;
#pragma unroll
            for (int ks = 0; ks < 2; ++ks) {
                const bf16x8 aP = *(const LAS bf16x8*)(P + (16 * mt + r) * 72 + ks * 32 + quad * 8);
                const bf16x8 aQ = *(const LAS bf16x8*)(Q + (16 * mt + r) * 72 + ks * 32 + quad * 8);
#pragma unroll
                for (int nt = 0; nt < 4; ++nt) { const int e = 16 * (eh * 4 + nt) + r;
                    const bf16x8 bV = *(const LAS bf16x8*)(VT + e * 72 + ks * 32 + quad * 8);
                    const bf16x8 bS = sfr[dir][ks][nt];
                    acc[nt] = __builtin_amdgcn_mfma_f32_16x16x32_bf16(aP, bV, acc[nt], 0, 0, 0);
                    acc[nt] = __builtin_amdgcn_mfma_f32_16x16x32_bf16(aQ, bS, acc[nt], 0, 0, 0); }
            }
        }
#pragma unroll
        for (int nt = 0; nt < 4; ++nt)
#pragma unroll
            for (int j = 0; j < 4; ++j) O[(16 * mt + quad * 4 + j) * 132 + 16 * (eh * 4 + nt) + r] = acc[nt][j];
    }
    __syncthreads();
    {
        const int t = F.tid >> 3, es = F.tid & 7;
        float v[16]; float ss = 0.f;
#pragma unroll
        for (int i = 0; i < 16; ++i) { v[i] = O[t * 132 + es * 16 + i]; ss += v[i] * v[i]; }
        ss += __shfl_xor(ss, 1); ss += __shfl_xor(ss, 2); ss += __shfl_xor(ss, 4);
        const float rstd = rsqrtf(ss * (1.0f / 128.0f) + EPS);
        const float* gn = F.in[I_GLAN] + l * 128 + es * 16;
        const u32x4 g0 = og0, g1 = og1;
        const unsigned gw[8] = {g0.x, g0.y, g0.z, g0.w, g1.x, g1.y, g1.z, g1.w};
        unsigned ow[8];
#pragma unroll
        for (int i = 0; i < 8; ++i) { const float a = v[2 * i] * rstd * gn[2 * i] * siluf_(bflo(gw[i])), b = v[2 * i + 1] * rstd * gn[2 * i + 1] * siluf_(bfhi(gw[i])); ow[i] = cvt_pk_bf16(a, b); }
        bf16_t* dst = (bf16_t*)(F.ws + WS_R4) + (size_t)(row0 + t) * 512 + h * 128 + es * 16;
        *(u32x4*)dst = (u32x4){ow[0], ow[1], ow[2], ow[3]}; *(u32x4*)(dst + 8) = (u32x4){ow[4], ow[5], ow[6], ow[7]};
    }
}
__device__ __forceinline__ void conv_pass(const Ctx& F, int l, int c_sub, int g_sub) {
    const bf16_t* Z1 = (const bf16_t*)(F.ws + WS_Z1B);
    bf16_t* ubuf = (bf16_t*)(F.ws + WS_R4) + (size_t)MT * 512;
    const float* cw = F.in[I_CONVW] + (size_t)l * 3 * 512;
    const int nth = g_sub * 512;
    for (int idx = c_sub * 512 + F.tid; idx < MT * 64; idx += nth) {
        const int row = idx >> 6, c0 = (idx & 63) * 8;
        const int Lm = row < NCTX ? 256 : 64, pos = row & (Lm - 1);
        const bf16_t* zr = Z1 + (size_t)row * NZA + c0;
        const u32x4 sb = *(const u32x4*)(zr);
        const u32x4 z0 = {0u, 0u, 0u, 0u};
        const u32x4 c1 = *(const u32x4*)(zr + 512), x1 = *(const u32x4*)(zr + 1024);
        const u32x4 cm = pos != 0 ? *(const u32x4*)(zr - NZA + 512) : z0, xm = pos != 0 ? *(const u32x4*)(zr - NZA + 1024) : z0;
        const u32x4 cp = pos != Lm - 1 ? *(const u32x4*)(zr + NZA + 512) : z0, xp = pos != Lm - 1 ? *(const u32x4*)(zr + NZA + 1024) : z0;
        const f32x4 w0a = *(const f32x4*)(cw + c0), w0b = *(const f32x4*)(cw + c0 + 4), w1a = *(const f32x4*)(cw + 512 + c0), w1b = *(const f32x4*)(cw + 512 + c0 + 4), w2a = *(const f32x4*)(cw + 1024 + c0), w2b = *(const f32x4*)(cw + 1024 + c0 + 4);
        unsigned ow[4];
#pragma unroll
        for (int i = 0; i < 4; ++i) {
            const float wl0 = i < 2 ? w0a[2 * i] : w0b[2 * i - 4], wh0 = i < 2 ? w0a[2 * i + 1] : w0b[2 * i - 3];
            const float wl1 = i < 2 ? w1a[2 * i] : w1b[2 * i - 4], wh1 = i < 2 ? w1a[2 * i + 1] : w1b[2 * i - 3];
            const float wl2 = i < 2 ? w2a[2 * i] : w2b[2 * i - 4], wh2 = i < 2 ? w2a[2 * i + 1] : w2b[2 * i - 3];
            const float lo = bflo(sb[i]) * (wl0 * bflo(cm[i]) * bflo(xm[i]) + wl1 * bflo(c1[i]) * bflo(x1[i]) + wl2 * bflo(cp[i]) * bflo(xp[i]));
            const float hi = bfhi(sb[i]) * (wh0 * bfhi(cm[i]) * bfhi(xm[i]) + wh1 * bfhi(c1[i]) * bfhi(x1[i]) + wh2 * bfhi(cp[i]) * bfhi(xp[i]));
            ow[i] = cvt_pk_bf16(lo, hi);
        }
        *(u32x4*)(ubuf + (size_t)row * 512 + c0) = (u32x4){ow[0], ow[1], ow[2], ow[3]};
    }
}


#define XB_TMO      128
#define XB_XCNT(j)  (256  + 64 * (j))
#define XB_XSUB(j)  (1280 + 64 * (j))
#define XB_XGEN(j)  (2304 + 64 * (j))
#define XB_TOP      3328
#define XB_TOPGEN   3392
#define XCD_BAR_WORDS 3456
#define XB_SPIN_CAP (1u << 18)
__device__ __forceinline__ unsigned xb_ld(unsigned* p)              { return __hip_atomic_load(p, __ATOMIC_RELAXED, __HIP_MEMORY_SCOPE_AGENT); }
__device__ __forceinline__ unsigned xb_add(unsigned* p, unsigned v) { return __hip_atomic_fetch_add(p, v, __ATOMIC_RELAXED, __HIP_MEMORY_SCOPE_AGENT); }
__device__ __forceinline__ unsigned xb_xcc_id() { return (unsigned)__builtin_amdgcn_s_getreg((3 << 11) | 20) & 0xFu; }
#define XB_SPIN(cond, bar) do { unsigned _sp = 0; while (cond) { __builtin_amdgcn_s_sleep(1); \
    if ((++_sp & 255u) == 0u) { if (xb_ld(&(bar)[XB_TMO])) break; if (_sp > XB_SPIN_CAP) { atomicAdd(&(bar)[XB_TMO], 1u); break; } } } } while (0)
struct XcdBarrier { unsigned* bar; unsigned x; volatile LAS unsigned* st; };
__device__ __forceinline__ void xcd_barrier_complete(unsigned* bar, unsigned x, unsigned& nloc, unsigned& nx) {
    const unsigned G = gridDim.x * gridDim.y * gridDim.z;
    unsigned sum, cnt, mine, sp = 0u;
    for (;;) {
        sum = 0u; cnt = 0u; mine = 0u;
#pragma unroll
        for (unsigned j = 0; j < 16; ++j) { const unsigned c = xb_ld(&bar[XB_XCNT(j)]); sum += c; cnt += (c > 0u) ? 1u : 0u; mine = (j == x) ? c : mine; }
        if (sum == G) break;
        __builtin_amdgcn_s_sleep(1);
        if ((++sp & 255u) == 0u) { if (xb_ld(&bar[XB_TMO])) break; if (sp > XB_SPIN_CAP) { atomicAdd(&bar[XB_TMO], 1u); break; } }
    }
    nloc = mine > 0u ? mine : 1u; nx = cnt > 0u ? cnt : 1u;
}
__device__ __forceinline__ void xcd_barrier(const XcdBarrier& b) {
    asm volatile("s_waitcnt vmcnt(0)" ::: "memory");
    __syncthreads();
    if (threadIdx.x == 0) {
        unsigned* bar = b.bar;
        __builtin_amdgcn_s_waitcnt(0);
        unsigned nloc = b.st[0], nx = b.st[1];
        if (nloc == 0u) { xcd_barrier_complete(bar, b.x, nloc, nx); b.st[0] = nloc; b.st[1] = nx; }
        const unsigned old = xb_add(&bar[XB_XSUB(b.x)], 1u);
        const unsigned gen = old / nloc;
        if (old + 1u == (gen + 1u) * nloc) {
            __builtin_amdgcn_fence(__ATOMIC_RELEASE, "agent");
            asm volatile("s_waitcnt vmcnt(0)" ::: "memory");
            const unsigned og = xb_add(&bar[XB_TOP], 1u);
            const unsigned tg = og / nx;
            if (og + 1u == (tg + 1u) * nx) xb_add(&bar[XB_TOPGEN], 1u);
            else XB_SPIN(xb_ld(&bar[XB_TOPGEN]) == tg, bar);
            __builtin_amdgcn_fence(__ATOMIC_ACQUIRE, "agent");
            xb_add(&bar[XB_XGEN(b.x)], 1u);
            asm volatile("s_waitcnt vmcnt(0)" ::: "memory");
        } else {
            XB_SPIN(xb_ld(&bar[XB_XGEN(b.x)]) == gen, bar);
            __builtin_amdgcn_fence(__ATOMIC_ACQUIRE, "agent");
            asm volatile("s_waitcnt vmcnt(0)" ::: "memory");
        }
    }
    __syncthreads();
}
#define CG_SYNC() do { asm volatile("s_waitcnt vmcnt(0) lgkmcnt(0)" ::: "memory"); __syncthreads(); \
    grid.sync(); __builtin_amdgcn_fence(__ATOMIC_ACQUIRE, "agent"); asm volatile("s_waitcnt vmcnt(0)" ::: "memory"); } while (0)
#define GRID_SYNC() do { XcdBarrier _b; _b.bar = (unsigned*)(F.ws + WS_BAR); _b.x = xb_xcc_id(); _b.st = (volatile LAS unsigned*)(F.lds + LDS_MISC); xcd_barrier(_b); } while (0)
#define LAYER_BODY() do { \
        REFRESH(); \
        if (l == 0 || !early) { \
            if (PH(1)) REP(1) p1_convert(F, l, 0, F.bid, F.G); \
            if (PH(2)) REP(2) p1_fold(F, l, F.bid, F.G); \
            if (PH(3)) REP(3) p1_cgen(F, l == 0, F.bid, F.G); \
        } else { \
            if (PH(1)) p1_convert(F, l, 0, F.bid, F.G); \
        } \
        if (PH(4)) REP(4) norm_pass(F, l == 0 ? 0 : 1, F.in[I_N1] + l * DM, mods_l, 0, DM, l != 0); \
        GRID_SYNC(); REFRESH(); \
        if (PH(5)) REP(5) { \
            pg8::Gemm g{H, (const bf16_t*)(ws + WS_WIN), MT, NZ1, DM}; pg8::StaticOrder S; S.init(MT, NZ1, F.G, F.bid); \
            pg8::EpiBf16<0> E{Z1, NZA, 2, 0, 0}; \
            pg8::gemm_phase<pg8::EpiBf16<0>, pg8::StaticOrder, true, true>(F.lds, g, S, E); \
        } \
        if (PH(6)) REP(6) { \
            pg8::Gemm g{(const bf16_t*)(ws + WS_WPT), H, NPT, MT, DM}; pg8::StaticOrder S; S.init(NPT, MT, F.G, F.bid); \
            pg8::EpiPT E{(bf16_t*)(ws + WS_PT), (bf16_t*)(ws + WS_PT + 8 * MiB), (bf16_t*)(ws + WS_GKT)}; \
            pg8::gemm_phase<pg8::EpiPT, pg8::StaticOrder, true, true>(F.lds, g, S, E); \
        } \
        GRID_SYNC(); REFRESH(); \
        if (PH(21)) pt_fold(F); \
        GRID_SYNC(); REFRESH(); \
        if (F.bid < half) { \
            if (PH(7)) REP(7) { \
            pg8::Gemm g{(const bf16_t*)(ws + WS_C), (const bf16_t*)(ws + WS_PT2), 4096, 2048, 4096}; pg8::StaticOrder S; S.init(4096, 2048, half, F.bid); \
            pg8::EpiBf16<0> E{(bf16_t*)(ws + WS_R4) + (size_t)2 * MT * 512, 512, 1, NCTX, 4096}; \
            pg8::gemm_phase<pg8::EpiBf16<0>, pg8::StaticOrder, true, true>(F.lds, g, S, E); \
            } \
        } else { \
            const int cs = F.bid - half, gs = F.G - half; \
            if (PH(8)) REP(8) { \
                pg8::Gemm g{(const bf16_t*)(ws + WS_C256), (const bf16_t*)(ws + WS_PT), 256, 8192, 512}; pg8::StaticOrder S; S.init(256, 8192, gs, cs); \
                pg8::EpiBf16<0> E{(bf16_t*)(ws + WS_R4) + (size_t)2 * MT * 512, 512, 1, 0, 256}; \
                pg8::gemm_phase<pg8::EpiBf16<0>, pg8::StaticOrder, true, true>(F.lds, g, S, E); \
            } \
            if (PH(9)) REP(9) { GkW W; int hW = -1; const bool bal = (gs == 128); const int it0 = !bal ? cs : (cs < 32 ? cs : 256 + cs - 32), itE = (bal && cs < 32) ? 256 : NCH * 4, itS = !bal ? gs : (cs < 32 ? 32 : 96); for (int it = it0; it < itE; it += itS) { if ((it & 3) != hW) { hW = it & 3; gla_load_w(F, l, hW, W); } gla_pass1(F, l, it, W); } } \
        } \
        if (PH(10)) REP(10) conv_pass(F, l, F.bid, F.G); \
        GRID_SYNC(); REFRESH(); \
        if (PH(11)) REP(11) gla_scan(F, l); \
        GRID_SYNC(); REFRESH(); \
        if (PH(12)) REP(12) { GkW W; int hW = -1; for (int it = F.bid; it < NCH * 4; it += F.G) { if ((it & 3) != hW) { hW = it & 3; gla_load_w(F, l, hW, W); } gla_pass3(F, l, it, W); } } \
        __syncthreads(); \
        if (PH(13)) REP(13) { \
            pg8::Gemm g{H, (const bf16_t*)(ws + WS_WMG), MT, NMG, DM}; pg8::StaticOrder S; S.init(MT, NMG, F.G, F.bid); \
            pg8::EpiBf16<2> E{(bf16_t*)(ws + WS_ZG), NMG, 0, 0, 0}; \
            pg8::gemm_phase<pg8::EpiBf16<2>, pg8::StaticOrder, true, true>(F.lds, g, S, E); \
        } \
        GRID_SYNC(); REFRESH(); \
        if (PH(14)) REP(14) { \
            pg8::Gemm g{(const bf16_t*)(ws + WS_R4), (const bf16_t*)(ws + WS_WABC), 3 * MT, 3 * DM, 512}; pg8::BranchOrder S; S.init(F.G, F.bid); \
            pg8::EpiBranch E{(const bf16_t*)(ws + WS_ZG), (float*)(ws + WS_Z1), (bf16_t*)(ws + WS_YBF)}; \
            pg8::gemm_phase<pg8::EpiBranch, pg8::BranchOrder, true, true>(F.lds, g, S, E); \
        } \
        GRID_SYNC(); REFRESH(); \
        if (PH(15)) REP(15) { \
            pg8::Gemm g{(const bf16_t*)(ws + WS_YBF), (const bf16_t*)(ws + WS_WO), MT, DM, DM}; pg8::StaticOrder S; S.init(MT, DM, F.G, F.bid); \
            pg8::EpiRes E{F.out, mods_l + 2 * DM, RSC}; \
            pg8::gemm_phase<pg8::EpiRes, pg8::StaticOrder, true, true>(F.lds, g, S, E); \
        } \
        if (early && l < DEPTH - 1 && F.bid >= 64) { __syncthreads(); p1_cgen(F, false, F.bid - 64, F.G - 64); } \
        GRID_SYNC(); REFRESH(); \
        if (PH(16)) REP(16) norm_pass(F, 1, F.in[I_N2] + l * DM, mods_l, 3 * DM, 4 * DM, false); \
        GRID_SYNC(); REFRESH(); \
        if (PH(17)) REP(17) { \
            pg8::Gemm g{H, (const bf16_t*)(ws + WS_WUP), MT, 2 * DFF, DM}; pg8::StaticOrder S; S.init(MT, 2 * DFF, F.G, F.bid); \
            pg8::EpiSwiglu E{Z1}; \
            pg8::gemm_phase<pg8::EpiSwiglu, pg8::StaticOrder, true, true>(F.lds, g, S, E); \
        } \
        GRID_SYNC(); REFRESH(); \
        if (PH(18)) { \
            { pg8::Gemm g{Z1, (const bf16_t*)(ws + WS_WDN), MT, DM, DFF, 0}; pg8::LatOrder S; S.init(F.G, F.bid); \
              pg8::EpiRes E{F.out, mods_l + 5 * DM, RSC}; \
              pg8::gemm_phase<pg8::EpiRes, pg8::LatOrder, true, true>(F.lds, g, S, E); } \
            { pg8::Gemm g{Z1, (const bf16_t*)(ws + WS_WDN), MT, DM, DFF, DFF / 2}; pg8::CtxSplitOrder S; S.init(F.G, F.bid, DFF / 2); \
              pg8::EpiPart E{(bf16_t*)(ws + WS_XP), mods_l + 5 * DM}; \
              pg8::gemm_phase<pg8::EpiPart, pg8::CtxSplitOrder, true, true>(F.lds, g, S, E); } \
        } \
        if (early && l < DEPTH - 1 && F.bid < 128) { __syncthreads(); p1_fold(F, l + 1, F.bid, 128); } \
        GRID_SYNC(); REFRESH(); \
     \
    } while (0)
__global__ void __launch_bounds__(512, 2) fwd_megakernel(Args args) {
    extern __shared__ __attribute__((aligned(16))) unsigned char lds_raw[];
    cg::grid_group grid = cg::this_grid();
    Ctx F;
    F.lds = (LAS unsigned char*)lds_raw;
    F.tid = threadIdx.x; F.lane = F.tid & 63; F.wave = __builtin_amdgcn_readfirstlane(F.tid >> 6);
    F.G = gridDim.x; F.bid = blockIdx.x;
    unsigned char* ws; const float* mods; const float* mods_l; bf16_t* H; bf16_t* Z1; int l = 0;
    REFRESH();
    const int half = F.G >> 1;
    const bool early = F.G > 128;

#ifndef PHMASK
#define PHMASK 0xFFFFFF
#endif
#define PH(k) ((PHMASK >> (k)) & 1)
#ifndef RPMASK
#define RPMASK 0
#endif
#define RSC 1.0f
#define REP(k) for (int _rp = 0; _rp < 1 + ((RPMASK >> (k)) & 1); ++_rp)
    if (F.tid < 64) ((LAS unsigned*)(F.lds + 131072))[F.tid] = 0u;
    __syncthreads();
    if (F.tid == 0) (void)xb_add(&((unsigned*)(F.ws + WS_BAR))[XB_XCNT(xb_xcc_id())], 1u);
    if (PH(0)) p0_mods(F);
    CG_SYNC();

    l = 0; LAYER_BODY();
    l = 1; LAYER_BODY();
    l = 2; LAYER_BODY();
    l = 3; LAYER_BODY();
    l = 0; REFRESH();
    if (!PH(11)) { float* os = F.out + (size_t)MT * DM; for (int i = F.bid * 512 + F.tid; i < 4194304; i += F.G * 512) os[i] = 0.f; }
    if (PH(19)) norm_pass(F, 2, F.in[I_NF], mods, 0, 0, true);
}

extern "C" void kernel_launch(void* const* d_in, const int* in_sizes, int n_in, void* d_out, int out_size, void* d_ws, size_t ws_size, hipStream_t stream) {
    static int grid = 0;
    if (grid == 0) {
        if (n_in != 23 || ws_size < WS_END) { fprintf(stderr, "kernel_launch: unexpected n_in %d / ws_size %zu (need %zu)\n", n_in, ws_size, (size_t)WS_END); grid = -1; return; }
        int dev = 0, cus = 0, per_cu = 0;
        hipGetDevice(&dev);
        hipDeviceGetAttribute(&cus, hipDeviceAttributeMultiprocessorCount, dev);
        hipFuncSetAttribute((const void*)fwd_megakernel, hipFuncAttributeMaxDynamicSharedMemorySize, LDS_BYTES);
        hipOccupancyMaxActiveBlocksPerMultiprocessor(&per_cu, (const void*)fwd_megakernel, 512, LDS_BYTES);
        (void)hipGetLastError();
        if (per_cu < 1) per_cu = 1;
        grid = cus;
    }
    if (grid < 0) return;
    (void)hipMemsetAsync((char*)d_ws + WS_BAR, 0, 16384, stream);
    Args a{};
    for (int i = 0; i < 23; ++i) a.in[i] = (const float*)d_in[i];
    a.out = (float*)d_out; a.ws = (unsigned char*)d_ws;
    void* params[] = {&a};
    hipError_t e = hipLaunchCooperativeKernel((const void*)fwd_megakernel, dim3(grid), dim3(512), params, LDS_BYTES, stream);
    if (e != hipSuccess) fprintf(stderr, "cooperative launch failed: %s (grid %d)\n", hipGetErrorString(e), grid);
}
```

```cpp
#include <hip/hip_runtime.h>
#include <hip/hip_cooperative_groups.h>
#include <cstdio>
#include <cstdint>
namespace cg = cooperative_groups;

#define GAS __attribute__((address_space(1)))
#define LAS __attribute__((address_space(3)))
typedef unsigned short bf16_t;
typedef short bf16x8 __attribute__((ext_vector_type(8)));
typedef float f32x4 __attribute__((ext_vector_type(4)));
typedef float f32x2 __attribute__((ext_vector_type(2)));
typedef unsigned u32x4 __attribute__((ext_vector_type(4)));
typedef unsigned u32x2 __attribute__((ext_vector_type(2)));

constexpr int DM = 1024, NCTX = 4096, MT = 20480, PIN = 6688, NMOD = 6144, DFF = 2816, DEPTH = 4;
constexpr int NZ1 = 3072, NZA = 1536, NPT = 1280, NMG = 3072, NCH = 320;
constexpr float EPS = 1e-6f;
constexpr size_t MiB = 1u << 20;
constexpr size_t WS_MODS = 0, WS_T4096 = 512 * 1024, WS_C256 = 1 * MiB, WS_GG = 2 * MiB, WS_GKT = 4 * MiB;
constexpr size_t WS_WIN = 6 * MiB, WS_WPT = 12 * MiB, WS_WMG = 15 * MiB, WS_WABC = 21 * MiB, WS_WO = 24 * MiB, WS_WUP = 26 * MiB, WS_WDN = 37 * MiB;
constexpr size_t WS_H = 43 * MiB, WS_Z1 = 83 * MiB, WS_Z1B = 143 * MiB, WS_SS = 203 * MiB, WS_YBF = 203 * MiB, WS_PT = 243 * MiB, WS_C = 283 * MiB, WS_ZG = 243 * MiB, WS_US = 347 * MiB, WS_R4 = 367 * MiB, WS_XP = 427 * MiB, WS_END = 443 * MiB;
constexpr int LDS_BYTES = 147456, LDS_MISC = 131072 + 64;
constexpr size_t WS_BAR = 3 * MiB, WS_PT2 = 315 * MiB;

typedef __bf16 bf16x2_t __attribute__((ext_vector_type(2)));
__device__ __forceinline__ unsigned cvt_pk_bf16(float lo, float hi) { const f32x2 v = {lo, hi}; const bf16x2_t b = __builtin_convertvector(v, bf16x2_t); return __builtin_bit_cast(unsigned, b); }
__device__ __forceinline__ float bf2f(unsigned short x) { return __uint_as_float(((unsigned)x) << 16); }
__device__ __forceinline__ float bflo(unsigned w) { return __uint_as_float(w << 16); }
__device__ __forceinline__ float bfhi(unsigned w) { return __uint_as_float(w & 0xffff0000u); }
__device__ __forceinline__ float sigmoidf_(float x) { return 1.0f / (1.0f + __expf(-x)); }
__device__ __forceinline__ float siluf_(float x) { return x / (1.0f + __expf(-x)); }
__device__ __forceinline__ float logsigf_(float x) { return fminf(x, 0.0f) - __logf(1.0f + __expf(-fabsf(x))); }
__device__ __forceinline__ float fin_(float v) { return v; }
__device__ __forceinline__ float wave_sum(float v) {
#pragma unroll
    for (int o = 1; o < 64; o <<= 1) v += __shfl_xor(v, o);
    return v;
}

namespace pg8 {
constexpr int BM = 256, BK = 64, HALF = 128, HTB = HALF * BK * 2, STAGE_BYTES = 8 * HTB, NXCD = 8, WGM = 8;
__host__ __device__ __forceinline__ int lds_byte(int r, int c) { const int st = (r >> 4) * 2 + (c >> 5), rr = r & 15, cc = c & 31, ob = rr * 64 + cc * 2; return st * 1024 + (ob ^ (((ob >> 9) & 1) << 5)); }
__host__ __device__ __forceinline__ void stage_rc(int b, int& R, int& C) { const int st = b / 1024, sb = b % 1024, swz = sb ^ (((sb >> 9) & 1) << 5); R = (st >> 1) * 16 + swz / 64; C = (st & 1) * 32 + (swz % 64) / 2; }
__host__ __device__ __forceinline__ int perm32(int rho) { const int n = rho >> 4, i = rho & 15; return 8 * (i >> 2) + 4 * n + (i & 3); }

struct Unit { int pm, pn, koff, ks; };
struct Gemm { const bf16_t* A; const bf16_t* Bt; int M, N, K; int Kl; };

struct StaticOrder {
    int nM, nN, nwg, G, c;
    __device__ void init(int M, int N, int G_, int c_) { nM = M / BM; nN = N / BM; nwg = nM * nN; G = G_; c = c_; }
    __device__ __forceinline__ void map(int L, Unit& u) const {
        int wgid = L; { const int q = nwg / NXCD, r = nwg % NXCD, xcd = wgid % NXCD, off = wgid / NXCD; wgid = (xcd < r ? xcd * (q + 1) : r * (q + 1) + (xcd - r) * q) + off; }
        const int nig = WGM * nN, gid = wgid / nig, fm = gid * WGM, gsz = (nM - fm) < WGM ? (nM - fm) : WGM;
        u.pm = fm + ((wgid % nig) % gsz); u.pn = (wgid % nig) / gsz; u.koff = 0; u.ks = 0;
    }
    __device__ bool next(int i, Unit& u) const {
        const long L = (long)i * G + c; if (L >= nwg) return false;
        map((int)L, u); return true;
    }
};
struct BranchOrder {
    StaticOrder so;
    __device__ void init(int G_, int c_) { so.init(MT, DM, G_, c_); }
    __device__ bool next(int i, Unit& u) const {
        const int T = i / 3, br = i - 3 * T;
        const long L = (long)T * so.G + so.c; if (L >= so.nwg) return false;
        so.map((int)L, u); u.pm += br * (MT / BM); u.pn += br * (DM / BM); return true;
    }
};

struct LatOrder {
    StaticOrder so;
    __device__ void init(int G_, int c_) { so.init(MT - NCTX, DM, G_, c_); }
    __device__ bool next(int i, Unit& u) const { if (!so.next(i, u)) return false; u.pm += NCTX / BM; return true; }
};
struct CtxSplitOrder {
    int G, c, Kl;
    __device__ void init(int G_, int c_, int Kl_) { G = G_; c = c_; Kl = Kl_; }
    __device__ bool next(int i, Unit& u) const {
        int idx;
        if (G >= 128) { if (i > 0) return false; idx = c - (G - 128); if (idx < 0) return false; }
        else { idx = i * G + c; if (idx >= 128) return false; }
        u.ks = idx >> 6; const int t = idx & 63; u.pm = t >> 2; u.pn = t & 3; u.koff = u.ks * Kl; return true;
    }
};

#define PG8_ACC const f32x4 (&acc)[2][2][4][2]
__device__ __forceinline__ u32x4 pack8(f32x4 v0, f32x4 v1) { u32x4 w; w.x = cvt_pk_bf16(v0[0], v0[1]); w.y = cvt_pk_bf16(v0[2], v0[3]); w.z = cvt_pk_bf16(v1[0], v1[1]); w.w = cvt_pk_bf16(v1[2], v1[3]); return w; }

template <int ACT> struct EpiBf16 {
    static constexpr bool PERM = true, AFTER_DRAIN = false;
    bf16_t* O; int ldc; int mode; int R0, L;
    __device__ __forceinline__ void operator()(PG8_ACC, const Unit& u, int wr, int wc, int fr, int fq) const {
        int rb = u.pm * BM, cb = u.pn * BM;
        if (mode == 1) { rb = R0 + (u.pn >> 1) * L + u.pm * BM; cb = (u.pn & 1) * BM; }
        bf16_t* Ob = O;
        if (mode == 2 && u.pn >= 6) { cb -= 6 * BM; Ob = O + (size_t)MT * NZA; }
        const int row0 = rb + wr * 64 + fr, col0 = cb + wc * 32 + 8 * fq;
#pragma unroll
        for (int ai = 0; ai < 2; ++ai)
#pragma unroll
            for (int m = 0; m < 4; ++m) { bf16_t* rowp = Ob + (size_t)(row0 + ai * HALF + m * 16) * ldc + col0;
#pragma unroll
                for (int bj = 0; bj < 2; ++bj) { f32x4 v0 = acc[ai][bj][m][0], v1 = acc[ai][bj][m][1];
                    if (ACT == 2) {
#pragma unroll
                        for (int j = 0; j < 4; ++j) { v0[j] = sigmoidf_(v0[j]); v1[j] = sigmoidf_(v1[j]); } }
                    *(u32x4*)(rowp + bj * HALF) = pack8(v0, v1); } }
    }
};
struct EpiPT {
    static constexpr bool PERM = true, AFTER_DRAIN = false;
    bf16_t* PTc; bf16_t* PTl; bf16_t* GKT;
    __device__ __forceinline__ void operator()(PG8_ACC, const Unit& u, int wr, int wc, int fr, int fq) const {
        const int ct0 = wc * 32 + 8 * fq;
        if (u.pm < 4) {
            const int s = u.pm >> 1, chb = (u.pm & 1) * 256;
            bf16_t* base; size_t rstride;
            if (u.pn < 16) { base = PTc + (size_t)u.pn * 512 * 512 + s * 256; rstride = 512; }
            else { const int q = u.pn - 16; base = PTl + (size_t)(q >> 4) * 512 * 8192 + s * 4096 + (q & 15) * 256; rstride = 8192; }
#pragma unroll
            for (int ai = 0; ai < 2; ++ai)
#pragma unroll
                for (int m = 0; m < 4; ++m) { const int ch = chb + ai * HALF + wr * 64 + m * 16 + fr; bf16_t* rowp = base + (size_t)ch * rstride + ct0;
#pragma unroll
                    for (int bj = 0; bj < 2; ++bj) *(u32x4*)(rowp + bj * HALF) = pack8(acc[ai][bj][m][0], acc[ai][bj][m][1]); }
        } else if (wr == 0) {
#pragma unroll
            for (int m = 0; m < 2; ++m) { const int r = m * 16 + fr; bf16_t* rowp = GKT + (size_t)r * MT + u.pn * BM + ct0;
#pragma unroll
                for (int bj = 0; bj < 2; ++bj) *(u32x4*)(rowp + bj * HALF) = pack8(acc[0][bj][m][0], acc[0][bj][m][1]); }
        }
    }
};
struct EpiBranch {
    static constexpr bool PERM = true, AFTER_DRAIN = false;
    const bf16_t* ZG; float* yacc; bf16_t* ybf;
    __device__ __forceinline__ void operator()(PG8_ACC, const Unit& u, int wr, int wc, int fr, int fq) const {
        const int br = u.pn >> 2, pn = u.pn & 3, pm = u.pm - br * (MT / BM);
        const int row0 = pm * BM + wr * 64 + fr, col0 = pn * BM + wc * 32 + 8 * fq;
#pragma unroll
        for (int ai = 0; ai < 2; ++ai)
#pragma unroll
            for (int mp = 0; mp < 2; ++mp) {
                u32x4 gq[2][2]; f32x4 yin[2][2][2];
#pragma unroll
                for (int mm = 0; mm < 2; ++mm)
#pragma unroll
                    for (int bj = 0; bj < 2; ++bj) { const size_t row = (size_t)(row0 + ai * HALF + (2 * mp + mm) * 16); const int col = col0 + bj * HALF;
                        gq[mm][bj] = *(const u32x4*)(ZG + row * NMG + br * DM + col);
                        if (br != 0) { const float* yp = yacc + row * DM + col; yin[mm][bj][0] = *(const f32x4*)yp; yin[mm][bj][1] = *(const f32x4*)(yp + 4); } }
                asm volatile("" ::: "memory");
#pragma unroll
                for (int mm = 0; mm < 2; ++mm)
#pragma unroll
                    for (int bj = 0; bj < 2; ++bj) { const int m = 2 * mp + mm; const size_t row = (size_t)(row0 + ai * HALF + m * 16); const int col = col0 + bj * HALF;
                        const u32x4 g = gq[mm][bj];
                        f32x4 v0 = acc[ai][bj][m][0], v1 = acc[ai][bj][m][1];
                        v0[0] *= bflo(g.x); v0[1] *= bfhi(g.x); v0[2] *= bflo(g.y); v0[3] *= bfhi(g.y);
                        v1[0] *= bflo(g.z); v1[1] *= bfhi(g.z); v1[2] *= bflo(g.w); v1[3] *= bfhi(g.w);
                        float* yp = yacc + row * DM + col;
                        if (br != 0) { v0 += yin[mm][bj][0]; v1 += yin[mm][bj][1]; }
                        if (br != 2) { *(f32x4*)yp = v0; *(f32x4*)(yp + 4) = v1; }
                        else *(u32x4*)(ybf + row * DM + col) = pack8(v0, v1); }
                asm volatile("" ::: "memory");
            }
    }
};
struct EpiRes {
    static constexpr bool PERM = false, AFTER_DRAIN = false;
    float* x; const float* gate; float rsc;
    __device__ __forceinline__ void operator()(PG8_ACC, const Unit& u, int wr, int wc, int fr, int fq) const {
        const int cond = u.pm < 16 ? 0 : 1 + ((u.pm - 16) >> 4);
        const int col0 = u.pn * BM + wc * 32 + 4 * fq;
        const float* gp = gate + (size_t)cond * NMOD + col0;
        f32x4 gv[2][2];
#pragma unroll
        for (int bj = 0; bj < 2; ++bj)
#pragma unroll
            for (int n = 0; n < 2; ++n) gv[bj][n] = *(const f32x4*)(gp + bj * HALF + n * 16) * rsc;
#pragma unroll
        for (int ai = 0; ai < 2; ++ai) {
            float* rowb = x + (size_t)(u.pm * BM + ai * HALF + wr * 64 + fr) * DM + col0;
            f32x4 xin[4][2][2];
#pragma unroll
            for (int m = 0; m < 4; ++m)
#pragma unroll
                for (int bj = 0; bj < 2; ++bj)
#pragma unroll
                    for (int n = 0; n < 2; ++n) xin[m][bj][n] = *(const f32x4*)(rowb + (size_t)m * 16 * DM + bj * HALF + n * 16);
            asm volatile("" ::: "memory");
#pragma unroll
            for (int m = 0; m < 4; ++m)
#pragma unroll
                for (int bj = 0; bj < 2; ++bj)
#pragma unroll
                    for (int n = 0; n < 2; ++n) *(f32x4*)(rowb + (size_t)m * 16 * DM + bj * HALF + n * 16) = xin[m][bj][n] + gv[bj][n] * acc[ai][bj][m][n];
            asm volatile("" ::: "memory");
        }
    }
};
struct EpiPart {
    static constexpr bool PERM = true, AFTER_DRAIN = false;
    bf16_t* XP; const float* gate;
    __device__ __forceinline__ void operator()(PG8_ACC, const Unit& u, int wr, int wc, int fr, int fq) const {
        const int row0 = u.pm * BM + wr * 64 + fr, col0 = u.pn * BM + wc * 32 + 8 * fq;
        f32x4 gv[2][2];
#pragma unroll
        for (int bj = 0; bj < 2; ++bj)
#pragma unroll
            for (int n = 0; n < 2; ++n) gv[bj][n] = *(const f32x4*)(gate + col0 + bj * HALF + 4 * n);
        bf16_t* base = XP + (size_t)u.ks * NCTX * DM;
#pragma unroll
        for (int ai = 0; ai < 2; ++ai)
#pragma unroll
            for (int m = 0; m < 4; ++m) { bf16_t* rowp = base + (size_t)(row0 + ai * HALF + m * 16) * DM + col0;
#pragma unroll
                for (int bj = 0; bj < 2; ++bj) *(u32x4*)(rowp + bj * HALF) = pack8(acc[ai][bj][m][0] * gv[bj][0], acc[ai][bj][m][1] * gv[bj][1]); }
    }
};
struct EpiSwiglu {
    static constexpr bool PERM = true, AFTER_DRAIN = false;
    bf16_t* FF;
    __device__ __forceinline__ void operator()(PG8_ACC, const Unit& u, int wr, int wc, int fr, int fq) const {
        const int row0 = u.pm * BM + wr * 64 + fr, col0 = u.pn * HALF + wc * 32 + 8 * fq;
#pragma unroll
        for (int ai = 0; ai < 2; ++ai)
#pragma unroll
            for (int m = 0; m < 4; ++m) { f32x4 v0, v1;
#pragma unroll
                for (int j = 0; j < 4; ++j) { v0[j] = siluf_(acc[ai][0][m][0][j]) * acc[ai][1][m][0][j]; v1[j] = siluf_(acc[ai][0][m][1][j]) * acc[ai][1][m][1][j]; }
                *(u32x4*)(FF + (size_t)(row0 + ai * HALF + m * 16) * DFF + col0) = pack8(v0, v1); }
    }
};

template <class Epi, class Sched, bool ALIGN_EPI = false, bool SP2 = false>
__device__ __forceinline__ void gemm_phase(LAS unsigned char* lds, const Gemm g, const Sched& S, const Epi& E) {
    int tid_ = threadIdx.x; asm volatile("" : "+v"(tid_));
    const int tid = tid_, wid = __builtin_amdgcn_readfirstlane(tid >> 6), lane = tid & 63, wr = wid >> 2, wc = wid & 3, fr = lane & 15, fq = lane >> 4;
    const int K = g.K, nt = (g.Kl ? g.Kl : g.K) / BK;
    unsigned voffA[2], voffB[2];
#pragma unroll
    for (int i = 0; i < 2; ++i) { int R, C; stage_rc(tid * 16 + i * 8192, R, C); const int Rb = Epi::PERM ? ((R & ~31) + perm32(R & 31)) : R;
        voffA[i] = (unsigned)(R * K + C) * 2u; voffB[i] = (unsigned)(Rb * K + C) * 2u; }
    const size_t kstep = (size_t)(BK * 2);
    const size_t hstep = (size_t)HALF * K * 2;
    const size_t tstep = 2 * hstep;
    const unsigned ldsw = (unsigned)wid * 1024u;
    const int aoff = lds_byte(wr * 64 + fr, fq * 8), boff = lds_byte(wc * 32 + fr, fq * 8);
#define PG8_SA(b, h) (((b) * 2 + (h)) * HTB)
#define PG8_SB(b, h) ((4 + (b) * 2 + (h)) * HTB)
#define PG8_STAGE(bufoff, gbase, voff) do { _Pragma("unroll") for (int _i = 0; _i < 2; ++_i) \
        __builtin_amdgcn_global_load_lds((const unsigned*)((const char*)(gbase) + (voff)[_i]), (LAS unsigned*)(lds + (bufoff) + ldsw + _i * 8192), 16, 0, 0); } while (0)
#define PG8_LDA(dst, b, h) do { _Pragma("unroll") for (int m = 0; m < 4; ++m) _Pragma("unroll") for (int k = 0; k < 2; ++k) dst[m][k] = *(const LAS bf16x8*)(lds + PG8_SA(b, h) + aoff + m * 2048 + k * 1024); } while (0)
#define PG8_LDB(dst, b, h) do { _Pragma("unroll") for (int n = 0; n < 2; ++n) _Pragma("unroll") for (int k = 0; k < 2; ++k) dst[n][k] = *(const LAS bf16x8*)(lds + PG8_SB(b, h) + boff + n * 2048 + k * 1024); } while (0)
#define PG8_MMA(ai, bj, At, Bt) do { __builtin_amdgcn_s_setprio(1); _Pragma("unroll") for (int m = 0; m < 4; ++m) _Pragma("unroll") for (int n = 0; n < 2; ++n) _Pragma("unroll") for (int k = 0; k < 2; ++k) \
        acc[ai][bj][m][n] = __builtin_amdgcn_mfma_f32_16x16x32_bf16(Bt[n][k], At[m][k], acc[ai][bj][m][n], 0, 0, 0); __builtin_amdgcn_s_setprio(0); } while (0)
#define PG8_WAIT_V(n) asm volatile("s_waitcnt vmcnt(" #n ")" ::: "memory")
#define PG8_WAIT_L(n) asm volatile("s_waitcnt lgkmcnt(" #n ")" ::: "memory")
#define PG8_BAR __builtin_amdgcn_s_barrier()
#define PG8_SCHED __builtin_amdgcn_sched_barrier(0)
    Unit cur, nxt; int ui = 0;
    if (!S.next(0, cur)) return;
    f32x4 acc[2][2][4][2];
#pragma unroll
    for (int a = 0; a < 2; ++a)
#pragma unroll
        for (int b = 0; b < 2; ++b)
#pragma unroll
            for (int m = 0; m < 4; ++m)
#pragma unroll
                for (int n = 0; n < 2; ++n) acc[a][b][m][n] = (f32x4){0.f, 0.f, 0.f, 0.f};
    bf16x8 At[4][2], B0[2][2], B1[2][2];
    const char* cA = (const char*)g.A + (size_t)cur.pm * tstep + (size_t)cur.koff * 2; const char* cB = (const char*)g.Bt + (size_t)cur.pn * tstep + (size_t)cur.koff * 2;
    if constexpr (SP2) {
        PG8_STAGE(PG8_SB(0, 0), cB, voffB); PG8_STAGE(PG8_SB(0, 1), cB + hstep, voffB); PG8_STAGE(PG8_SA(0, 0), cA, voffA); PG8_STAGE(PG8_SA(0, 1), cA + hstep, voffA);
        if (wr == 1) PG8_BAR;
        PG8_WAIT_V(2); PG8_BAR;
        PG8_STAGE(PG8_SB(1, 0), cB + kstep, voffB); PG8_STAGE(PG8_SA(1, 0), cA + kstep, voffA); PG8_STAGE(PG8_SB(1, 1), cB + hstep + kstep, voffB);
        PG8_WAIT_V(6); PG8_BAR;
    } else {
        PG8_STAGE(PG8_SB(0, 0), cB, voffB); PG8_STAGE(PG8_SA(0, 0), cA, voffA); PG8_STAGE(PG8_SB(0, 1), cB + hstep, voffB); PG8_STAGE(PG8_SA(0, 1), cA + hstep, voffA);
        if (wr == 1) PG8_BAR;
        PG8_WAIT_V(4); PG8_BAR;
        PG8_STAGE(PG8_SB(1, 0), cB + kstep, voffB); PG8_STAGE(PG8_SA(1, 0), cA + kstep, voffA); PG8_STAGE(PG8_SB(1, 1), cB + hstep + kstep, voffB);
        PG8_WAIT_V(6); PG8_BAR;
    }
    for (;;) {
        const bool has_next = S.next(ui + 1, nxt);
        const char* nA = has_next ? (const char*)g.A + (size_t)nxt.pm * tstep + (size_t)nxt.koff * 2 : cA; const char* nB = has_next ? (const char*)g.Bt + (size_t)nxt.pn * tstep + (size_t)nxt.koff * 2 : cB;
        for (int t = 0; t < nt; t += 2) {
            const bool last = (t == nt - 2);
            const char* a1 = cA + (size_t)(t + 1) * kstep;
            const char* a2 = last ? nA : cA + (size_t)(t + 2) * kstep; const char* b2 = last ? nB : cB + (size_t)(t + 2) * kstep;
            const char* a3 = a2 + kstep; const char* b3 = b2 + kstep;
            if constexpr (SP2) {
            PG8_LDB(B0, 0, 0); PG8_LDB(B1, 0, 1); PG8_SCHED; PG8_LDA(At, 0, 0); PG8_STAGE(PG8_SA(1, 1), a1 + hstep, voffA);
            PG8_WAIT_V(8); PG8_WAIT_L(0); PG8_BAR; PG8_MMA(0, 0, At, B0); PG8_MMA(0, 1, At, B1); PG8_BAR; PG8_SCHED;
            PG8_LDA(At, 0, 1); PG8_STAGE(PG8_SB(0, 0), b2, voffB); PG8_STAGE(PG8_SB(0, 1), b2 + hstep, voffB); PG8_STAGE(PG8_SA(0, 0), a2, voffA);
            PG8_WAIT_V(8); PG8_WAIT_L(0); PG8_BAR; PG8_MMA(1, 0, At, B0); PG8_MMA(1, 1, At, B1); PG8_BAR; PG8_SCHED;
            PG8_LDB(B0, 1, 0); PG8_LDB(B1, 1, 1); PG8_SCHED; PG8_LDA(At, 1, 0); PG8_STAGE(PG8_SA(0, 1), a2 + hstep, voffA);
            PG8_WAIT_V(8); PG8_WAIT_L(0); PG8_BAR; PG8_MMA(0, 0, At, B0); PG8_MMA(0, 1, At, B1); PG8_BAR; PG8_SCHED;
            PG8_LDA(At, 1, 1); PG8_STAGE(PG8_SB(1, 0), b3, voffB); PG8_STAGE(PG8_SB(1, 1), b3 + hstep, voffB); PG8_STAGE(PG8_SA(1, 0), a3, voffA);
            PG8_WAIT_V(8); PG8_WAIT_L(0); PG8_BAR; PG8_MMA(1, 0, At, B0); PG8_MMA(1, 1, At, B1); PG8_BAR; PG8_SCHED;
            } else {
            PG8_LDB(B0, 0, 0); PG8_SCHED; PG8_LDA(At, 0, 0); PG8_STAGE(PG8_SA(1, 1), a1 + hstep, voffA);
            PG8_WAIT_L(8); PG8_BAR; PG8_WAIT_L(0); PG8_MMA(0, 0, At, B0); PG8_BAR; PG8_SCHED;
            PG8_LDB(B1, 0, 1); PG8_STAGE(PG8_SB(0, 0), b2, voffB);
            PG8_BAR; PG8_WAIT_L(0); PG8_MMA(0, 1, At, B1); PG8_BAR;
            PG8_LDA(At, 0, 1); PG8_STAGE(PG8_SA(0, 0), a2, voffA);
            PG8_BAR; PG8_WAIT_L(0); PG8_MMA(1, 0, At, B0); PG8_BAR; PG8_SCHED;
            PG8_STAGE(PG8_SB(0, 1), b2 + hstep, voffB);
            PG8_WAIT_V(6); PG8_BAR; PG8_MMA(1, 1, At, B1); PG8_BAR;
            PG8_LDB(B0, 1, 0); PG8_SCHED; PG8_LDA(At, 1, 0); PG8_STAGE(PG8_SA(0, 1), a2 + hstep, voffA);
            PG8_WAIT_L(8); PG8_BAR; PG8_WAIT_L(0); PG8_MMA(0, 0, At, B0); PG8_BAR; PG8_SCHED;
            PG8_LDB(B1, 1, 1); PG8_STAGE(PG8_SB(1, 0), b3, voffB);
            PG8_BAR; PG8_WAIT_L(0); PG8_MMA(0, 1, At, B1); PG8_BAR;
            PG8_LDA(At, 1, 1); PG8_STAGE(PG8_SA(1, 0), a3, voffA);
            PG8_BAR; PG8_WAIT_L(0); PG8_MMA(1, 0, At, B0); PG8_BAR; PG8_SCHED;
            PG8_STAGE(PG8_SB(1, 1), b3 + hstep, voffB);
            PG8_WAIT_V(6); PG8_BAR; PG8_MMA(1, 1, At, B1); PG8_BAR;
            }
        }
        if constexpr (ALIGN_EPI) { if (wr == 0) PG8_BAR; }
        E(acc, cur, wr, wc, fr, fq);
        if (!has_next) break;
#pragma unroll
        for (int a = 0; a < 2; ++a)
#pragma unroll
            for (int b = 0; b < 2; ++b)
#pragma unroll
                for (int m = 0; m < 4; ++m)
#pragma unroll
                    for (int n = 0; n < 2; ++n) acc[a][b][m][n] = (f32x4){0.f, 0.f, 0.f, 0.f};
        cur = nxt; cA = nA; cB = nB; ++ui;
        if constexpr (ALIGN_EPI) { if (wr == 1) PG8_BAR; }
    }
    PG8_WAIT_V(0);
    if constexpr (!ALIGN_EPI) { if (wr == 0) PG8_BAR; }
    PG8_BAR;
#undef PG8_SA
#undef PG8_SB
#undef PG8_STAGE
#undef PG8_LDA
#undef PG8_LDB
#undef PG8_MMA
#undef PG8_WAIT_V
#undef PG8_WAIT_L
#undef PG8_BAR
#undef PG8_SCHED
}
}

struct Args { const float* in[23]; float* out; unsigned char* ws; };
enum { I_XP = 0, I_XS, I_STATE, I_C, I_CCTX, I_WADA, I_BADA, I_N1, I_N2, I_WIN, I_WGKF, I_BGKF, I_WGKB, I_BGKB, I_GLAN, I_WA, I_CONVW, I_WB, I_WC, I_WO, I_WUP, I_WDN, I_NF };

struct Ctx {
    LAS unsigned char* lds;
    int tid, lane, wave, G, bid;
    const float* const* in; float* out; unsigned char* ws;
};
__device__ __forceinline__ const Args* args_fresh() { const Args* p = (const Args*)__builtin_amdgcn_kernarg_segment_ptr(); asm volatile("" : "+s"(p)); return p; }
#define REFRESH() do { { int _t = threadIdx.x; asm volatile("" : "+v"(_t)); F.tid = _t; F.lane = _t & 63; F.wave = __builtin_amdgcn_readfirstlane(_t >> 6); } const Args* _a = args_fresh(); F.in = _a->in; F.out = _a->out; F.ws = _a->ws; ws = F.ws; mods = (const float*)(ws + WS_MODS); H = (bf16_t*)(ws + WS_H); Z1 = (bf16_t*)(ws + WS_Z1); mods_l = mods + (size_t)l * 5 * NMOD; } while (0)


__device__ __forceinline__ void p0_mods(const Ctx& F) {
    LAS float* sc = (LAS float*)F.lds;
    LAS float* part = (LAS float*)(F.lds + 20480);
    for (int i = F.tid; i < 5 * DM; i += 512) { const int c = i >> 10, k = i & 1023; const float v = c == 0 ? F.in[I_CCTX][k] : F.in[I_C][(c - 1) * DM + k]; sc[i] = siluf_(v); }
    __syncthreads();
    float* mods = (float*)(F.ws + WS_MODS);
    for (int item = F.bid; item < DEPTH * 96; item += F.G) {
        const int l = item / 96, jb = item % 96;
        const float* w = F.in[I_WADA] + (size_t)l * DM * NMOD + jb * 64 + F.lane;
        float a0 = 0.f, a1 = 0.f, a2 = 0.f, a3 = 0.f, a4 = 0.f;
        const int k0 = F.wave * 128;
#pragma unroll 32
        for (int k = 0; k < 128; ++k) { const float wv = w[(size_t)(k0 + k) * NMOD];
            a0 += sc[k0 + k] * wv; a1 += sc[1024 + k0 + k] * wv; a2 += sc[2048 + k0 + k] * wv; a3 += sc[3072 + k0 + k] * wv; a4 += sc[4096 + k0 + k] * wv; }
        part[(F.wave * 5 + 0) * 64 + F.lane] = a0; part[(F.wave * 5 + 1) * 64 + F.lane] = a1; part[(F.wave * 5 + 2) * 64 + F.lane] = a2;
        part[(F.wave * 5 + 3) * 64 + F.lane] = a3; part[(F.wave * 5 + 4) * 64 + F.lane] = a4;
        __syncthreads();
        if (F.tid < 320) { const int c = F.tid >> 6, j = F.tid & 63; float s = F.in[I_BADA][l * NMOD + jb * 64 + j];
#pragma unroll
            for (int w8 = 0; w8 < 8; ++w8) s += part[(w8 * 5 + c) * 64 + j];
            mods[(size_t)(l * 5 + c) * NMOD + jb * 64 + j] = s; }
        __syncthreads();
    }
    float* T = (float*)(F.ws + WS_T4096);
    for (int j = F.bid * 512 + F.tid; j < 4096; j += F.G * 512) T[j] = cospif((float)j * (1.0f / 2048.0f));
    { u32x4* z = (u32x4*)((bf16_t*)(F.ws + WS_WPT) + (size_t)1056 * DM); const int n16 = 224 * DM * 2 / 16;
      for (int i = F.bid * 512 + F.tid; i < n16; i += F.G * 512) z[i] = (u32x4){0u, 0u, 0u, 0u}; }
}

__device__ __forceinline__ void transpose_item(const float* W, int ldw, int K, int c0, bf16_t* WT, int r0, int k0, LAS float* scr, int lane) {
#pragma unroll 8
    for (int i = 0; i < 32; ++i) { const int kk = 2 * i + (lane >> 5); scr[kk * 33 + (lane & 31)] = W[(size_t)(k0 + kk) * ldw + c0 + (lane & 31)]; }
    asm volatile("s_waitcnt lgkmcnt(0)" ::: "memory");
    const int c = lane & 7;
#pragma unroll
    for (int j = 0; j < 4; ++j) { const int n = (lane >> 3) + 8 * j; const LAS float* s = scr + (8 * c) * 33 + n;
        u32x4 o; o.x = cvt_pk_bf16(s[0 * 33], s[1 * 33]); o.y = cvt_pk_bf16(s[2 * 33], s[3 * 33]); o.z = cvt_pk_bf16(s[4 * 33], s[5 * 33]); o.w = cvt_pk_bf16(s[6 * 33], s[7 * 33]);
        *(u32x4*)(WT + (size_t)(r0 + n) * K + k0 + 8 * c) = o; }
    asm volatile("s_waitcnt lgkmcnt(0)" ::: "memory");
}
__device__ __forceinline__ void p1_convert(const Ctx& F, int l, int part, int cs, int gs) {
    LAS float* scr = (LAS float*)(F.lds + F.wave * 8448);
    const int gw = cs * 8 + F.wave, NGW = gs * 8;
    constexpr int I_IN = 16 * 96, I_GK = 16, I_MG = 16 * 96, I_ABC = 8 * 32, I_O = 16 * 32, I_UP = 16 * 176, I_DN = 44 * 32;
    constexpr int NITEMS = I_IN + I_GK + I_MG + 3 * I_ABC + I_O + I_UP + I_DN;
    const float* win = F.in[I_WIN] + (size_t)l * DM * PIN;
    const int it_lo = part == 2 ? NITEMS - I_DN : 0, it_hi = part == 1 ? NITEMS - I_DN : NITEMS;
    for (int it = it_lo + gw; it < it_hi; it += NGW) {
        int r = it;
        if (r < I_IN) { const int kb = r / 96, nb = r % 96, r0 = nb * 32; transpose_item(win, PIN, DM, r0 < 1536 ? r0 : r0 + 32, (bf16_t*)(F.ws + WS_WIN), r0, kb * 64, scr, F.lane); continue; } r -= I_IN;
        if (r < I_GK) { transpose_item(win, PIN, DM, 1536, (bf16_t*)(F.ws + WS_WPT), 1024, r * 64, scr, F.lane); continue; } r -= I_GK;
        if (r < I_MG) { const int kb = r / 96, nb = r % 96; transpose_item(win, PIN, DM, 3616 + nb * 32, (bf16_t*)(F.ws + WS_WMG), nb * 32, kb * 64, scr, F.lane); continue; } r -= I_MG;
        if (r < 3 * I_ABC) { const int br = r / I_ABC, q = r % I_ABC, kb = q / 32, nb = q % 32; const float* w = F.in[br == 0 ? I_WA : (br == 1 ? I_WB : I_WC)] + (size_t)l * 512 * DM;
            transpose_item(w, DM, 512, nb * 32, (bf16_t*)(F.ws + WS_WABC) + (size_t)br * DM * 512, nb * 32, kb * 64, scr, F.lane); continue; } r -= 3 * I_ABC;
        if (r < I_O) { const int kb = r / 32, nb = r % 32; transpose_item(F.in[I_WO] + (size_t)l * DM * DM, DM, DM, nb * 32, (bf16_t*)(F.ws + WS_WO), nb * 32, kb * 64, scr, F.lane); continue; } r -= I_O;
        if (r < I_UP) { const int kb = r / 176, nb = r % 176, r0 = nb * 32, t = r0 >> 8, w = r0 & 255; const int c0 = w < 128 ? t * 128 + w : DFF + t * 128 + (w - 128);
            transpose_item(F.in[I_WUP] + (size_t)l * DM * 2 * DFF, 2 * DFF, DM, c0, (bf16_t*)(F.ws + WS_WUP), r0, kb * 64, scr, F.lane); continue; } r -= I_UP;
        { const int kb = r / 32, nb = r % 32; transpose_item(F.in[I_WDN] + (size_t)l * DFF * DM, DM, DFF, nb * 32, (bf16_t*)(F.ws + WS_WDN), nb * 32, kb * 64, scr, F.lane); }
    }
}
__device__ __forceinline__ void p1_fold(const Ctx& F, int l, int cs, int gs) {
    LAS float* Wl = (LAS float*)F.lds;
    LAS float* T128 = (LAS float*)(F.lds + 64 * 129 * 4);
    const float* T = (const float*)(F.ws + WS_T4096);
    const float* win = F.in[I_WIN] + (size_t)l * DM * PIN;
    bf16_t* WPT = (bf16_t*)(F.ws + WS_WPT);
    for (int item = cs; item < 256; item += gs) {
        const int g = item >> 6, kb = (item >> 2) & 15, qt = item & 3;
        __syncthreads();
        for (int i = F.tid; i < 64 * 128; i += 512) { const int k = i >> 7, c = i & 127; Wl[k * 129 + c] = win[(size_t)(kb * 64 + k) * PIN + 3104 + g * 128 + c]; }
        if (F.tid < 128) T128[F.tid] = T[F.tid * 32] * 0.08838834764831845f;
        __syncthreads();
        const int k = F.lane;
        for (int mi = 0; mi < 8; ++mi) {
            const int q = qt * 64 + F.wave * 8 + mi, s = q >> 7, m = q & 127;
            float a = 0.f;
#pragma unroll 8
            for (int c = 0; c < 128; ++c) a += Wl[k * 129 + c] * T128[(c * m + s * 96) & 127];
            const unsigned short b = (unsigned short)(cvt_pk_bf16(a, 0.f) & 0xffffu);
            WPT[(size_t)(s * 512 + g * 128 + m) * DM + kb * 64 + k] = b;
        }
    }
    __syncthreads();
}
__device__ __forceinline__ void p1_cgen(const Ctx& F, bool do256, int cs, int gs) {
    LAS float* T = (LAS float*)F.lds;
    const float* Tg = (const float*)(F.ws + WS_T4096);
    __syncthreads();
    for (int i = F.tid; i < 4096; i += 512) T[i] = Tg[i];
    __syncthreads();
    u32x4* C = (u32x4*)(F.ws + WS_C);
    const int nth = gs * 512;
    for (int it = cs * 512 + F.tid; it < 4096 * 512; it += nth) {
        const int n = it >> 9, kp = (it & 511) * 8, s = kp >> 11, k0 = kp & 2047;
        float v[8];
#pragma unroll
        for (int i = 0; i < 8; ++i) { const int k = k0 + i; const int idx = (s && k == 0) ? (n * 2048) : (n * k + s * 1024); v[i] = T[idx & 4095] * (1.0f / 64.0f); }
        u32x4 o; o.x = cvt_pk_bf16(v[0], v[1]); o.y = cvt_pk_bf16(v[2], v[3]); o.z = cvt_pk_bf16(v[4], v[5]); o.w = cvt_pk_bf16(v[6], v[7]);
        C[it] = o;
    }
    if (do256) {
        u32x4* C2 = (u32x4*)(F.ws + WS_C256);
        for (int it = cs * 512 + F.tid; it < 256 * 64; it += nth) {
            const int n = it >> 6, kp = (it & 63) * 8, s = kp >> 8, k0 = kp & 255;
            float v[8];
#pragma unroll
            for (int i = 0; i < 8; ++i) v[i] = T[((((n * (k0 + i)) & 255) << 4) + s * 1024) & 4095] * (1.0f / 16.0f);
            u32x4 o; o.x = cvt_pk_bf16(v[0], v[1]); o.y = cvt_pk_bf16(v[2], v[3]); o.z = cvt_pk_bf16(v[4], v[5]); o.w = cvt_pk_bf16(v[6], v[7]);
            C2[it] = o;
        }
    }
    __syncthreads();
}

struct FoldIn { u32x4 a, lo, s, slo; unsigned short hi, shi, mid; };
__device__ __forceinline__ void fold_load(const bf16_t* PTl, int it, FoldIn& I) {
    const int row = it >> 8, m = it & 255;
    const bf16_t* pc = PTl + (size_t)row * 8192; const bf16_t* ps = pc + 4096;
    I.a = *(const u32x4*)(pc + 8 * m); I.lo = *(const u32x4*)(pc + 8 * (511 - m)); I.s = *(const u32x4*)(ps + 8 * m); I.slo = *(const u32x4*)(ps + 8 * (511 - m));
    I.hi = pc[8 * (512 - m)]; I.shi = ps[8 * (512 - m) - (m == 0 ? 8 : 0)]; I.mid = pc[2048];
}
__device__ __forceinline__ void fold_finish(bf16_t* PT2, int it, const FoldIn& I) {
    const int row = it >> 8, m = it & 255;
    const u32x4 a = I.a, lo = I.lo, s = I.s, slo = I.slo;
    float av[8] = {bflo(a.x), bfhi(a.x), bflo(a.y), bfhi(a.y), bflo(a.z), bfhi(a.z), bflo(a.w), bfhi(a.w)};
    float sv[8] = {bflo(s.x), bfhi(s.x), bflo(s.y), bfhi(s.y), bflo(s.z), bfhi(s.z), bflo(s.w), bfhi(s.w)};
    const float lv[8] = {bflo(lo.x), bfhi(lo.x), bflo(lo.y), bfhi(lo.y), bflo(lo.z), bfhi(lo.z), bflo(lo.w), bfhi(lo.w)};
    const float tv[8] = {bflo(slo.x), bfhi(slo.x), bflo(slo.y), bfhi(slo.y), bflo(slo.z), bfhi(slo.z), bflo(slo.w), bfhi(slo.w)};
    av[0] += (m > 0) ? bf2f(I.hi) : 0.f; sv[0] -= (m > 0) ? bf2f(I.shi) : 0.f;
#pragma unroll
    for (int j = 1; j < 8; ++j) { av[j] += lv[8 - j]; sv[j] -= tv[8 - j]; }
    if (m == 0) sv[0] = bf2f(I.mid);
    u32x4 o1, o2;
    o1.x = cvt_pk_bf16(av[0], av[1]); o1.y = cvt_pk_bf16(av[2], av[3]); o1.z = cvt_pk_bf16(av[4], av[5]); o1.w = cvt_pk_bf16(av[6], av[7]);
    o2.x = cvt_pk_bf16(sv[0], sv[1]); o2.y = cvt_pk_bf16(sv[2], sv[3]); o2.z = cvt_pk_bf16(sv[4], sv[5]); o2.w = cvt_pk_bf16(sv[6], sv[7]);
    *(u32x4*)(PT2 + (size_t)row * 4096 + 8 * m) = o1; *(u32x4*)(PT2 + (size_t)row * 4096 + 2048 + 8 * m) = o2;
}
__device__ __forceinline__ void pt_fold(const Ctx& F) {
    const bf16_t* PTl = (const bf16_t*)(F.ws + WS_PT + 8 * MiB);
    bf16_t* PT2 = (bf16_t*)(F.ws + WS_PT2);
    const int nth = F.G * 512, NI = 2048 * 256;
    int it = F.bid * 512 + F.tid;
    for (; it + nth < NI; it += 2 * nth) {
        FoldIn A, B; fold_load(PTl, it, A); fold_load(PTl, it + nth, B);
        fold_finish(PT2, it, A); fold_finish(PT2, it + nth, B);
    }
    if (it < NI) { FoldIn A; fold_load(PTl, it, A); fold_finish(PT2, it, A); }
}
__device__ __forceinline__ void norm_pass(const Ctx& F, int mode, const float* nw, const float* mods_l, int shoff, int scoff, bool addp) {
    const int gw = F.bid * 8 + F.wave, NGW = F.G * 8;
    bf16_t* H = (bf16_t*)(F.ws + WS_H);
    f32x4 wv[4];
#pragma unroll
    for (int j = 0; j < 4; ++j) wv[j] = *(const f32x4*)(nw + 4 * F.lane + 256 * j);
    constexpr int NR = 5;
    for (int r0 = gw; r0 < MT; r0 += NR * NGW) {
        f32x4 v[NR][4]; float s[NR]; u32x4 pq[NR][4];
        const bf16_t* XP = (const bf16_t*)(F.ws + WS_XP);
#pragma unroll
        for (int q = 0; q < NR; ++q) s[q] = 0.f;
#pragma unroll
        for (int q = 0; q < NR; ++q) { const int r = r0 + q * NGW;
            if (r < MT) {
                const float* src = (mode == 0) ? (r < NCTX ? F.in[I_XP] + (size_t)r * DM : F.in[I_XS] + (size_t)(r - NCTX) * DM) : F.out + (size_t)r * DM;
#pragma unroll
                for (int j = 0; j < 4; ++j) v[q][j] = *(const f32x4*)(src + 4 * F.lane + 256 * j);
                if (addp && r < NCTX) {
#pragma unroll
                    for (int j = 0; j < 4; ++j) { const u32x2 a = *(const u32x2*)(XP + (size_t)r * DM + 4 * F.lane + 256 * j), b = *(const u32x2*)(XP + (size_t)(NCTX + r) * DM + 4 * F.lane + 256 * j); pq[q][j] = (u32x4){a.x, a.y, b.x, b.y}; }
                }
            } }
#pragma unroll
        for (int q = 0; q < NR; ++q) { const int r = r0 + q * NGW;
            if (r < MT) {
                if (addp && r < NCTX) {
#pragma unroll
                    for (int j = 0; j < 4; ++j) { const u32x4 p = pq[q][j];
                        v[q][j].x += bflo(p.x) + bflo(p.z); v[q][j].y += bfhi(p.x) + bfhi(p.z); v[q][j].z += bflo(p.y) + bflo(p.w); v[q][j].w += bfhi(p.y) + bfhi(p.w);
                        if (mode != 2) *(f32x4*)(F.out + (size_t)r * DM + 4 * F.lane + 256 * j) = v[q][j]; }
                }
#pragma unroll
                for (int j = 0; j < 4; ++j) s[q] += (v[q][j].x * v[q][j].x + v[q][j].y * v[q][j].y) + (v[q][j].z * v[q][j].z + v[q][j].w * v[q][j].w);
                const float rstd = rsqrtf(wave_sum(s[q]) * (1.0f / DM) + EPS);
                if (mode == 2) {
#pragma unroll
                    for (int j = 0; j < 4; ++j) { f32x4 o = v[q][j] * rstd * wv[j]; o[0] = fin_(o[0]); o[1] = fin_(o[1]); o[2] = fin_(o[2]); o[3] = fin_(o[3]); *(f32x4*)(F.out + (size_t)r * DM + 4 * F.lane + 256 * j) = o; }
                } else {
                    if (mode == 0) {
#pragma unroll
                        for (int j = 0; j < 4; ++j) *(f32x4*)(F.out + (size_t)r * DM + 4 * F.lane + 256 * j) = v[q][j];
                    }
                    const int cond = r < NCTX ? 0 : 1 + ((r - NCTX) >> 12);
                    const float* mp = mods_l + (size_t)cond * NMOD;
#pragma unroll
                    for (int j = 0; j < 4; ++j) {
                        const f32x4 sh = *(const f32x4*)(mp + shoff + 4 * F.lane + 256 * j), scv = *(const f32x4*)(mp + scoff + 4 * F.lane + 256 * j);
                        const f32x4 o = v[q][j] * rstd * wv[j] * (scv + 1.0f) + sh;
                        u32x2 w; w.x = cvt_pk_bf16(o[0], o[1]); w.y = cvt_pk_bf16(o[2], o[3]);
                        *(u32x2*)(H + (size_t)r * DM + 4 * F.lane + 256 * j) = w;
                    }
                }
            } }
    }
}

struct GkW { float wf[16], wb[16], bf, bb; };
__device__ __forceinline__ void gla_load_w(const Ctx& F, int l, int h, GkW& W) {
    const int d = F.lane;
    const float* wgf = F.in[I_WGKF] + (size_t)l * 16 * 256 + h * 64 + d; const float* wgb = F.in[I_WGKB] + (size_t)l * 16 * 256 + h * 64 + d;
#pragma unroll
    for (int r = 0; r < 16; ++r) { W.wf[r] = wgf[r * 256]; W.wb[r] = wgb[r * 256]; }
    W.bf = F.in[I_BGKF][l * 256 + h * 64 + d]; W.bb = F.in[I_BGKB][l * 256 + h * 64 + d];
}
__device__ __forceinline__ void gla_decay(const Ctx& F, const GkW& W, LAS float* gk, LAS float* seg, float (&bF)[8], float (&bB)[8], float& totF, float& totB) {
    const int d = F.lane, w = F.wave;
#pragma unroll
    for (int i = 0; i < 8; ++i) { bF[i] = W.bf; bB[i] = W.bb; }
#pragma unroll
    for (int r = 0; r < 16; ++r) {
        const float wf = W.wf[r], wb = W.wb[r];
        const f32x4 f0 = *(const LAS f32x4*)(gk + r * 64 + 8 * w), f1 = *(const LAS f32x4*)(gk + r * 64 + 8 * w + 4);
        const f32x4 g0 = *(const LAS f32x4*)(gk + (16 + r) * 64 + 8 * w), g1 = *(const LAS f32x4*)(gk + (16 + r) * 64 + 8 * w + 4);
#pragma unroll
        for (int j = 0; j < 4; ++j) { bF[j] += f0[j] * wf; bF[4 + j] += f1[j] * wf; bB[j] += g0[j] * wb; bB[4 + j] += g1[j] * wb; }
        if ((r & 3) == 3) asm volatile("" ::: "memory");
    }
#pragma unroll
    for (int i = 0; i < 8; ++i) { bF[i] = logsigf_(bF[i]) * (1.0f / 16.0f); bB[i] = logsigf_(bB[i]) * (1.0f / 16.0f); }
#pragma unroll
    for (int i = 1; i < 8; ++i) bF[i] += bF[i - 1];
#pragma unroll
    for (int i = 6; i >= 0; --i) bB[i] += bB[i + 1];
    seg[w * 64 + d] = bF[7]; seg[(8 + w) * 64 + d] = bB[0];
    __syncthreads();
    float offF = 0.f, offB = 0.f; totF = 0.f; totB = 0.f;
#pragma unroll
    for (int w2 = 0; w2 < 8; ++w2) { const float sf = seg[w2 * 64 + d], sb = seg[(8 + w2) * 64 + d]; totF += sf; totB += sb; if (w2 < w) offF += sf; if (w2 > w) offB += sb; }
#pragma unroll
    for (int i = 0; i < 8; ++i) { bF[i] += offF; bB[i] += offB; }
}
__device__ __forceinline__ void gla_stage_gk(const Ctx& F, int row0, LAS float* gk) {
    const bf16_t* GKT = (const bf16_t*)(F.ws + WS_GKT);
    const int idx = F.tid * 4, r = idx >> 6, t = idx & 63;
    const u32x2 w = *(const u32x2*)(GKT + (size_t)r * MT + row0 + t);
    gk[idx] = bflo(w.x); gk[idx + 1] = bfhi(w.x); gk[idx + 2] = bflo(w.y); gk[idx + 3] = bfhi(w.y);
}
__device__ __forceinline__ void gla_stage_vt(const Ctx& F, int row0, int h, LAS bf16_t* VT) {
    const bf16_t* Z1 = (const bf16_t*)(F.ws + WS_Z1);
#pragma unroll
    for (int rep = 0; rep < 2; ++rep) { const int e = F.tid & 127, ts = (F.tid >> 7) + 4 * rep;
        unsigned short v[8];
#pragma unroll
        for (int i = 0; i < 8; ++i) v[i] = Z1[(size_t)(row0 + 8 * ts + i) * NZA + 512 + h * 128 + e];
        u32x4 o; o.x = v[0] | ((unsigned)v[1] << 16); o.y = v[2] | ((unsigned)v[3] << 16); o.z = v[4] | ((unsigned)v[5] << 16); o.w = v[6] | ((unsigned)v[7] << 16);
        *(LAS u32x4*)(VT + e * 72 + 8 * ts) = o; }
}
__device__ __forceinline__ void gla_pass1(const Ctx& F, int l, int item, const GkW& W) {
    const int h = item & 3, ci = item >> 2, row0 = ci * 64, w = F.wave, d = F.lane;
    LAS float* gk = (LAS float*)F.lds; LAS float* seg = (LAS float*)(F.lds + 8192);
    LAS bf16_t* KoF = (LAS bf16_t*)(F.lds + 12288); LAS bf16_t* KoB = (LAS bf16_t*)(F.lds + 21504); LAS bf16_t* VT = (LAS bf16_t*)(F.lds + 30720);
    const bf16_t* Z1 = (const bf16_t*)(F.ws + WS_Z1);
    unsigned short kraw[8], vraw[2][8];
#pragma unroll
    for (int i = 0; i < 8; ++i) kraw[i] = Z1[(size_t)(row0 + 8 * w + i) * NZA + 256 + h * 64 + d];
#pragma unroll
    for (int rep = 0; rep < 2; ++rep) { const int e = F.tid & 127, ts = (F.tid >> 7) + 4 * rep;
#pragma unroll
        for (int i = 0; i < 8; ++i) vraw[rep][i] = Z1[(size_t)(row0 + 8 * ts + i) * NZA + 512 + h * 128 + e]; }
    __syncthreads();
    gla_stage_gk(F, row0, gk);
    __syncthreads();
    float bF[8], bB[8], totF, totB;
    gla_decay(F, W, gk, seg, bF, bB, totF, totB);
    {
        float kf[8], kb[8];
#pragma unroll
        for (int i = 0; i < 8; ++i) { const float kv = bf2f(kraw[i]); kf[i] = kv * __expf(totF - bF[i]); kb[i] = kv * __expf(totB - bB[i]); }
        u32x4 o; o.x = cvt_pk_bf16(kf[0], kf[1]); o.y = cvt_pk_bf16(kf[2], kf[3]); o.z = cvt_pk_bf16(kf[4], kf[5]); o.w = cvt_pk_bf16(kf[6], kf[7]);
        *(LAS u32x4*)(KoF + d * 72 + 8 * w) = o;
        o.x = cvt_pk_bf16(kb[0], kb[1]); o.y = cvt_pk_bf16(kb[2], kb[3]); o.z = cvt_pk_bf16(kb[4], kb[5]); o.w = cvt_pk_bf16(kb[6], kb[7]);
        *(LAS u32x4*)(KoB + d * 72 + 8 * w) = o;
    }
#pragma unroll
    for (int rep = 0; rep < 2; ++rep) { const int e = F.tid & 127, ts = (F.tid >> 7) + 4 * rep;
        u32x4 o; o.x = vraw[rep][0] | ((unsigned)vraw[rep][1] << 16); o.y = vraw[rep][2] | ((unsigned)vraw[rep][3] << 16); o.z = vraw[rep][4] | ((unsigned)vraw[rep][5] << 16); o.w = vraw[rep][6] | ((unsigned)vraw[rep][7] << 16);
        *(LAS u32x4*)(VT + e * 72 + 8 * ts) = o; }
    float* GG = (float*)(F.ws + WS_GG);
    if (w == 0) { GG[(size_t)((0 * NCH + ci) * 4 + h) * 64 + d] = __expf(totF); GG[(size_t)((1 * NCH + ci) * 4 + h) * 64 + d] = __expf(totB); }
    __syncthreads();
    const int r = F.lane & 15, quad = F.lane >> 4;
    bf16_t* US = (bf16_t*)(F.ws + WS_US);
#pragma unroll
    for (int dir = 0; dir < 2; ++dir) {
        const LAS bf16_t* Ko = dir ? KoB : KoF;
        bf16_t* ub = US + (size_t)((dir * NCH + ci) * 4 + h) * 8192;
        bf16x8 bv[2];
#pragma unroll
        for (int ks = 0; ks < 2; ++ks) bv[ks] = *(const LAS bf16x8*)(VT + (16 * w + r) * 72 + ks * 32 + quad * 8);
#pragma unroll
        for (int mt = 0; mt < 4; ++mt) {
            f32x4 acc = {0.f, 0.f, 0.f, 0.f};
#pragma unroll
            for (int ks = 0; ks < 2; ++ks) { const bf16x8 a = *(const LAS bf16x8*)(Ko + (16 * mt + r) * 72 + ks * 32 + quad * 8); acc = __builtin_amdgcn_mfma_f32_16x16x32_bf16(a, bv[ks], acc, 0, 0, 0); }
            u32x2 o; o.x = cvt_pk_bf16(acc[0], acc[1]); o.y = cvt_pk_bf16(acc[2], acc[3]);
            *(u32x2*)(ub + (16 * w + r) * 64 + 16 * mt + quad * 4) = o;
        }
    }
}
__device__ __forceinline__ void gla_scan(const Ctx& F, int l) {
    const bf16_t* US = (const bf16_t*)(F.ws + WS_US); bf16_t* SS = (bf16_t*)(F.ws + WS_SS); const float* GG = (const float*)(F.ws + WS_GG);
    float* ostate = F.out + (size_t)MT * DM;
    const int nth = F.G * 512;
    for (int wid = F.bid * 512 + F.tid; wid < 131072 + 524288; wid += nth) {
        const bool lat = wid < 131072; const int q = lat ? wid : wid - 131072;
        const int p = q & 4095, chain = q >> 12, dir = chain & 1, h = (chain >> 1) & 3, b = chain >> 3;
        const int e = p >> 5, d = (p & 31) * 2;
        const int N = lat ? 64 : 4, cbase = lat ? 64 + b * 64 : b * 4;
        const size_t sidx = ((size_t)((((b * 4 + l) * 2 + dir) * 4 + h) * 64 + d)) * 128 + e;
        float s0 = 0.f, s1 = 0.f;
        if (lat) { s0 = F.in[I_STATE][sidx]; s1 = F.in[I_STATE][sidx + 128]; }
#define SCAN_BATCH(NB) do { unsigned uu[NB]; f32x2 gg[NB]; \
            _Pragma("unroll") for (int i = 0; i < NB; ++i) { const int n = dir ? (N - 1 - (n0 + i)) : (n0 + i); const size_t cb = (size_t)((dir * NCH + cbase + n) * 4 + h); \
                uu[i] = *(const unsigned*)(US + cb * 8192 + e * 64 + d); gg[i] = *(const f32x2*)(GG + cb * 64 + d); } \
            _Pragma("unroll") for (int i = 0; i < NB; ++i) { const int n = dir ? (N - 1 - (n0 + i)) : (n0 + i); const size_t cb = (size_t)((dir * NCH + cbase + n) * 4 + h); \
                *(unsigned*)(SS + cb * 8192 + e * 64 + d) = cvt_pk_bf16(s0, s1); \
                s0 = gg[i].x * s0 + bflo(uu[i]); s1 = gg[i].y * s1 + bfhi(uu[i]); } } while (0)
        if (lat) { for (int n0 = 0; n0 < 64; n0 += 8) SCAN_BATCH(8); }
        else { const int n0 = 0; SCAN_BATCH(4); }
#undef SCAN_BATCH
        if (!lat) { ostate[sidx] = fin_(s0); ostate[sidx + 128] = fin_(s1); }
    }
}
__device__ __forceinline__ void gla_pass3(const Ctx& F, int l, int item, const GkW& W) {
    const int h = item & 3, ci = item >> 2, row0 = ci * 64, w = F.wave, d = F.lane;
    LAS float* gk = (LAS float*)F.lds; LAS float* seg = (LAS float*)(F.lds + 8192);
    LAS bf16_t* QF = (LAS bf16_t*)(F.lds + 12288); LAS bf16_t* QB = (LAS bf16_t*)(F.lds + 21504); LAS bf16_t* KF = (LAS bf16_t*)(F.lds + 30720); LAS bf16_t* KB = (LAS bf16_t*)(F.lds + 39936);
    LAS bf16_t* VT = (LAS bf16_t*)(F.lds + 49152); LAS bf16_t* PF = (LAS bf16_t*)(F.lds + 67584); LAS bf16_t* PB = (LAS bf16_t*)(F.lds + 76800); LAS float* O = (LAS float*)(F.lds + 86016);
    const bf16_t* Z1 = (const bf16_t*)(F.ws + WS_Z1);
    unsigned short qraw[8], kraw[8], vraw[2][8];
#pragma unroll
    for (int i = 0; i < 8; ++i) { const bf16_t* zr = Z1 + (size_t)(row0 + 8 * w + i) * NZA + h * 64 + d; qraw[i] = zr[0]; kraw[i] = zr[256]; }
#pragma unroll
    for (int rep = 0; rep < 2; ++rep) { const int e = F.tid & 127, ts = (F.tid >> 7) + 4 * rep;
#pragma unroll
        for (int i = 0; i < 8; ++i) vraw[rep][i] = Z1[(size_t)(row0 + 8 * ts + i) * NZA + 512 + h * 128 + e]; }
    const bf16_t* ogp = Z1 + (size_t)(row0 + (F.tid >> 3)) * NZA + 1024 + h * 128 + (F.tid & 7) * 16;
    const u32x4 og0 = *(const u32x4*)ogp, og1 = *(const u32x4*)(ogp + 8);
    bf16x8 sfr[2][2][4];
    {
        const bf16_t* SSg = (const bf16_t*)(F.ws + WS_SS);
        const int r_ = F.lane & 15, quad_ = F.lane >> 4, eh_ = w >> 2;
#pragma unroll
        for (int dir = 0; dir < 2; ++dir) { const bf16_t* Sb = SSg + (size_t)((dir * NCH + ci) * 4 + h) * 8192;
#pragma unroll
            for (int ks = 0; ks < 2; ++ks)
#pragma unroll
                for (int nt = 0; nt < 4; ++nt) sfr[dir][ks][nt] = *(const bf16x8*)(Sb + (16 * (eh_ * 4 + nt) + r_) * 64 + ks * 32 + quad_ * 8); }
    }
    __syncthreads();
    gla_stage_gk(F, row0, gk);
    __syncthreads();
    float bF[8], bB[8], totF, totB;
    gla_decay(F, W, gk, seg, bF, bB, totF, totB);
#pragma unroll
    for (int i = 0; i < 8; ++i) { const int t = 8 * w + i;
        const float qv = bf2f(qraw[i]) * 0.125f, kv = bf2f(kraw[i]); const float ef = __expf(bF[i]), eb = __expf(bB[i]);
        const unsigned a = cvt_pk_bf16(qv * ef, kv / ef), b2 = cvt_pk_bf16(qv * eb, kv / eb);
        QF[t * 72 + d] = (unsigned short)(a & 0xffffu); KF[t * 72 + d] = (unsigned short)(a >> 16); QB[t * 72 + d] = (unsigned short)(b2 & 0xffffu); KB[t * 72 + d] = (unsigned short)(b2 >> 16); }
#pragma unroll
    for (int rep = 0; rep < 2; ++rep) { const int e = F.tid & 127, ts = (F.tid >> 7) + 4 * rep;
        u32x4 o; o.x = vraw[rep][0] | ((unsigned)vraw[rep][1] << 16); o.y = vraw[rep][2] | ((unsigned)vraw[rep][3] << 16); o.z = vraw[rep][4] | ((unsigned)vraw[rep][5] << 16); o.w = vraw[rep][6] | ((unsigned)vraw[rep][7] << 16);
        *(LAS u32x4*)(VT + e * 72 + 8 * ts) = o; }
    __syncthreads();
    const int r = F.lane & 15, quad = F.lane >> 4;
    {
        const int dir = w >> 2, mt = w & 3; const LAS bf16_t* Q = dir ? QB : QF; const LAS bf16_t* Kk = dir ? KB : KF; LAS bf16_t* P = dir ? PB : PF;
        f32x4 acc[4];
#pragma unroll
        for (int nt = 0; nt < 4; ++nt) acc[nt] = (f32x4){0.f, 0.f, 0.f, 0.f};
#pragma unroll
        for (int ks = 0; ks < 2; ++ks) { const bf16x8 a = *(const LAS bf16x8*)(Q + (16 * mt + r) * 72 + ks * 32 + quad * 8);
#pragma unroll
            for (int nt = 0; nt < 4; ++nt) { const bf16x8 b = *(const LAS bf16x8*)(Kk + (16 * nt + r) * 72 + ks * 32 + quad * 8); acc[nt] = __builtin_amdgcn_mfma_f32_16x16x32_bf16(a, b, acc[nt], 0, 0, 0); } }
#pragma unroll
        for (int nt = 0; nt < 4; ++nt)
#pragma unroll
            for (int j = 0; j < 4; ++j) { const int t = 16 * mt + quad * 4 + j, s = 16 * nt + r; const bool keep = dir ? (s >= t) : (s <= t);
                P[t * 72 + s] = (unsigned short)(cvt_pk_bf16(keep ? acc[nt][j] : 0.f, 0.f) & 0xffffu); }
    }
    __syncthreads();
    {
        const int mt = w & 3, eh = w >> 2;
        const bf16_t* US = (const bf16_t*)(F.ws + WS_SS);
        f32x4 acc[4];
#pragma unroll
        for (int nt = 0; nt < 4; ++nt) acc[nt] = (f32x4){0.f, 0.f, 0.f, 0.f};
#pragma unroll
        for (int dir = 0; dir < 2; ++dir) {
            const LAS bf16_t* P = dir ? PB : PF; const LAS bf16_t* Q = dir ? QB : QF;
            const bf16_t* Sb = US + (size_t)((dir * NCH + ci) * 4 + h) * 8192;
#pragma unroll
            for (int ks = 0; ks < 2; ++ks) {
                const bf16x8 aP = *(const LAS bf16x8*)(P + (16 * mt + r) * 72 + ks * 32 + quad * 8);
                const bf16x8 aQ = *(const LAS bf16x8*)(Q + (16 * mt + r) * 72 + ks * 32 + quad * 8);
#pragma unroll
                for (int nt = 0; nt < 4; ++nt) { const int e = 16 * (eh * 4 + nt) + r;
                    const bf16x8 bV = *(const LAS bf16x8*)(VT + e * 72 + ks * 32 + quad * 8);
                    const bf16x8 bS = sfr[dir][ks][nt];
                    acc[nt] = __builtin_amdgcn_mfma_f32_16x16x32_bf16(aP, bV, acc[nt], 0, 0, 0);
                    acc[nt] = __builtin_amdgcn_mfma_f32_16x16x32_bf16(aQ, bS, acc[nt], 0, 0, 0); }
            }
        }
#pragma unroll
        for (int nt = 0; nt < 4; ++nt)
#pragma unroll
            for (int j = 0; j < 4; ++j) O[(16 * mt + quad * 4 + j) * 132 + 16 * (eh * 4 + nt) + r] = acc[nt][j];
    }
    __syncthreads();
    {
        const int t = F.tid >> 3, es = F.tid & 7;
        float v[16]; float ss = 0.f;
#pragma unroll
        for (int i = 0; i < 16; ++i) { v[i] = O[t * 132 + es * 16 + i]; ss += v[i] * v[i]; }
        ss += __shfl_xor(ss, 1); ss += __shfl_xor(ss, 2); ss += __shfl_xor(ss, 4);
        const float rstd = rsqrtf(ss * (1.0f / 128.0f) + EPS);
        const float* gn = F.in[I_GLAN] + l * 128 + es * 16;
        const u32x4 g0 = og0, g1 = og1;
        const unsigned gw[8] = {g0.x, g0.y, g0.z, g0.w, g1.x, g1.y, g1.z, g1.w};
        unsigned ow[8];
#pragma unroll
        for (int i = 0; i < 8; ++i) { const float a = v[2 * i] * rstd * gn[2 * i] * siluf_(bflo(gw[i])), b = v[2 * i + 1] * rstd * gn[2 * i + 1] * siluf_(bfhi(gw[i])); ow[i] = cvt_pk_bf16(a, b); }
        bf16_t* dst = (bf16_t*)(F.ws + WS_R4) + (size_t)(row0 + t) * 512 + h * 128 + es * 16;
        *(u32x4*)dst = (u32x4){ow[0], ow[1], ow[2], ow[3]}; *(u32x4*)(dst + 8) = (u32x4){ow[4], ow[5], ow[6], ow[7]};
    }
}
__device__ __forceinline__ void conv_pass(const Ctx& F, int l, int c_sub, int g_sub) {
    const bf16_t* Z1 = (const bf16_t*)(F.ws + WS_Z1B);
    bf16_t* ubuf = (bf16_t*)(F.ws + WS_R4) + (size_t)MT * 512;
    const float* cw = F.in[I_CONVW] + (size_t)l * 3 * 512;
    const int nth = g_sub * 512;
    for (int idx = c_sub * 512 + F.tid; idx < MT * 64; idx += nth) {
        const int row = idx >> 6, c0 = (idx & 63) * 8;
        const int Lm = row < NCTX ? 256 : 64, pos = row & (Lm - 1);
        const bf16_t* zr = Z1 + (size_t)row * NZA + c0;
        const u32x4 sb = *(const u32x4*)(zr);
        const u32x4 z0 = {0u, 0u, 0u, 0u};
        const u32x4 c1 = *(const u32x4*)(zr + 512), x1 = *(const u32x4*)(zr + 1024);
        const u32x4 cm = pos != 0 ? *(const u32x4*)(zr - NZA + 512) : z0, xm = pos != 0 ? *(const u32x4*)(zr - NZA + 1024) : z0;
        const u32x4 cp = pos != Lm - 1 ? *(const u32x4*)(zr + NZA + 512) : z0, xp = pos != Lm - 1 ? *(const u32x4*)(zr + NZA + 1024) : z0;
        const f32x4 w0a = *(const f32x4*)(cw + c0), w0b = *(const f32x4*)(cw + c0 + 4), w1a = *(const f32x4*)(cw + 512 + c0), w1b = *(const f32x4*)(cw + 512 + c0 + 4), w2a = *(const f32x4*)(cw + 1024 + c0), w2b = *(const f32x4*)(cw + 1024 + c0 + 4);
        unsigned ow[4];
#pragma unroll
        for (int i = 0; i < 4; ++i) {
            const float wl0 = i < 2 ? w0a[2 * i] : w0b[2 * i - 4], wh0 = i < 2 ? w0a[2 * i + 1] : w0b[2 * i - 3];
            const float wl1 = i < 2 ? w1a[2 * i] : w1b[2 * i - 4], wh1 = i < 2 ? w1a[2 * i + 1] : w1b[2 * i - 3];
            const float wl2 = i < 2 ? w2a[2 * i] : w2b[2 * i - 4], wh2 = i < 2 ? w2a[2 * i + 1] : w2b[2 * i - 3];
            const float lo = bflo(sb[i]) * (wl0 * bflo(cm[i]) * bflo(xm[i]) + wl1 * bflo(c1[i]) * bflo(x1[i]) + wl2 * bflo(cp[i]) * bflo(xp[i]));
            const float hi = bfhi(sb[i]) * (wh0 * bfhi(cm[i]) * bfhi(xm[i]) + wh1 * bfhi(c1[i]) * bfhi(x1[i]) + wh2 * bfhi(cp[i]) * bfhi(xp[i]));
            ow[i] = cvt_pk_bf16(lo, hi);
        }
        *(u32x4*)(ubuf + (size_t)row * 512 + c0) = (u32x4){ow[0], ow[1], ow[2], ow[3]};
    }
}


#define XB_TMO      128
#define XB_XCNT(j)  (256  + 64 * (j))
#define XB_XSUB(j)  (1280 + 64 * (j))
#define XB_XGEN(j)  (2304 + 64 * (j))
#define XB_TOP      3328
#define XB_TOPGEN   3392
#define XCD_BAR_WORDS 3456
#define XB_SPIN_CAP (1u << 18)
__device__ __forceinline__ unsigned xb_ld(unsigned* p)              { return __hip_atomic_load(p, __ATOMIC_RELAXED, __HIP_MEMORY_SCOPE_AGENT); }
__device__ __forceinline__ unsigned xb_add(unsigned* p, unsigned v) { return __hip_atomic_fetch_add(p, v, __ATOMIC_RELAXED, __HIP_MEMORY_SCOPE_AGENT); }
__device__ __forceinline__ unsigned xb_xcc_id() { return (unsigned)__builtin_amdgcn_s_getreg((3 << 11) | 20) & 0xFu; }
#define XB_SPIN(cond, bar) do { unsigned _sp = 0; while (cond) { __builtin_amdgcn_s_sleep(1); \
    if ((++_sp & 255u) == 0u) { if (xb_ld(&(bar)[XB_TMO])) break; if (_sp > XB_SPIN_CAP) { atomicAdd(&(bar)[XB_TMO], 1u); break; } } } } while (0)
struct XcdBarrier { unsigned* bar; unsigned x; volatile LAS unsigned* st; };
__device__ __forceinline__ void xcd_barrier_complete(unsigned* bar, unsigned x, unsigned& nloc, unsigned& nx) {
    const unsigned G = gridDim.x * gridDim.y * gridDim.z;
    unsigned sum, cnt, mine, sp = 0u;
    for (;;) {
        sum = 0u; cnt = 0u; mine = 0u;
#pragma unroll
        for (unsigned j = 0; j < 16; ++j) { const unsigned c = xb_ld(&bar[XB_XCNT(j)]); sum += c; cnt += (c > 0u) ? 1u : 0u; mine = (j == x) ? c : mine; }
        if (sum == G) break;
        __builtin_amdgcn_s_sleep(1);
        if ((++sp & 255u) == 0u) { if (xb_ld(&bar[XB_TMO])) break; if (sp > XB_SPIN_CAP) { atomicAdd(&bar[XB_TMO], 1u); break; } }
    }
    nloc = mine > 0u ? mine : 1u; nx = cnt > 0u ? cnt : 1u;
}
__device__ __forceinline__ void xcd_barrier(const XcdBarrier& b) {
    asm volatile("s_waitcnt vmcnt(0)" ::: "memory");
    __syncthreads();
    if (threadIdx.x == 0) {
        unsigned* bar = b.bar;
        __builtin_amdgcn_s_waitcnt(0);
        unsigned nloc = b.st[0], nx = b.st[1];
        if (nloc == 0u) { xcd_barrier_complete(bar, b.x, nloc, nx); b.st[0] = nloc; b.st[1] = nx; }
        const unsigned old = xb_add(&bar[XB_XSUB(b.x)], 1u);
        const unsigned gen = old / nloc;
        if (old + 1u == (gen + 1u) * nloc) {
            __builtin_amdgcn_fence(__ATOMIC_RELEASE, "agent");
            asm volatile("s_waitcnt vmcnt(0)" ::: "memory");
            const unsigned og = xb_add(&bar[XB_TOP], 1u);
            const unsigned tg = og / nx;
            if (og + 1u == (tg + 1u) * nx) xb_add(&bar[XB_TOPGEN], 1u);
            else XB_SPIN(xb_ld(&bar[XB_TOPGEN]) == tg, bar);
            __builtin_amdgcn_fence(__ATOMIC_ACQUIRE, "agent");
            xb_add(&bar[XB_XGEN(b.x)], 1u);
            asm volatile("s_waitcnt vmcnt(0)" ::: "memory");
        } else {
            XB_SPIN(xb_ld(&bar[XB_XGEN(b.x)]) == gen, bar);
            __builtin_amdgcn_fence(__ATOMIC_ACQUIRE, "agent");
            asm volatile("s_waitcnt vmcnt(0)" ::: "memory");
        }
    }
    __syncthreads();
}
#define CG_SYNC() do { asm volatile("s_waitcnt vmcnt(0) lgkmcnt(0)" ::: "memory"); __syncthreads(); \
    grid.sync(); __builtin_amdgcn_fence(__ATOMIC_ACQUIRE, "agent"); asm volatile("s_waitcnt vmcnt(0)" ::: "memory"); } while (0)
#define GRID_SYNC() do { XcdBarrier _b; _b.bar = (unsigned*)(F.ws + WS_BAR); _b.x = xb_xcc_id(); _b.st = (volatile LAS unsigned*)(F.lds + LDS_MISC); xcd_barrier(_b); } while (0)
#define LAYER_BODY() do { \
        REFRESH(); \
        if (l == 0 || !early) { \
            if (PH(1)) REP(1) p1_convert(F, l, 0, F.bid, F.G); \
            if (PH(2)) REP(2) p1_fold(F, l, F.bid, F.G); \
            if (PH(3)) REP(3) p1_cgen(F, l == 0, F.bid, F.G); \
        } else { \
            if (PH(1)) p1_convert(F, l, 0, F.bid, F.G); \
        } \
        if (PH(4)) REP(4) norm_pass(F, l == 0 ? 0 : 1, F.in[I_N1] + l * DM, mods_l, 0, DM, l != 0); \
        GRID_SYNC(); REFRESH(); \
        if (PH(5)) REP(5) { \
            pg8::Gemm g{H, (const bf16_t*)(ws + WS_WIN), MT, NZ1, DM}; pg8::StaticOrder S; S.init(MT, NZ1, F.G, F.bid); \
            pg8::EpiBf16<0> E{Z1, NZA, 2, 0, 0}; \
            pg8::gemm_phase<pg8::EpiBf16<0>, pg8::StaticOrder, true, true>(F.lds, g, S, E); \
        } \
        if (PH(6)) REP(6) { \
            pg8::Gemm g{(const bf16_t*)(ws + WS_WPT), H, NPT, MT, DM}; pg8::StaticOrder S; S.init(NPT, MT, F.G, F.bid); \
            pg8::EpiPT E{(bf16_t*)(ws + WS_PT), (bf16_t*)(ws + WS_PT + 8 * MiB), (bf16_t*)(ws + WS_GKT)}; \
            pg8::gemm_phase<pg8::EpiPT, pg8::StaticOrder, true, true>(F.lds, g, S, E); \
        } \
        GRID_SYNC(); REFRESH(); \
        if (PH(21)) pt_fold(F); \
        GRID_SYNC(); REFRESH(); \
        if (F.bid < half) { \
            if (PH(7)) REP(7) { \
            pg8::Gemm g{(const bf16_t*)(ws + WS_C), (const bf16_t*)(ws + WS_PT2), 4096, 2048, 4096}; pg8::StaticOrder S; S.init(4096, 2048, half, F.bid); \
            pg8::EpiBf16<0> E{(bf16_t*)(ws + WS_R4) + (size_t)2 * MT * 512, 512, 1, NCTX, 4096}; \
            pg8::gemm_phase<pg8::EpiBf16<0>, pg8::StaticOrder, true, true>(F.lds, g, S, E); \
            } \
        } else { \
            const int cs = F.bid - half, gs = F.G - half; \
            if (PH(8)) REP(8) { \
                pg8::Gemm g{(const bf16_t*)(ws + WS_C256), (const bf16_t*)(ws + WS_PT), 256, 8192, 512}; pg8::StaticOrder S; S.init(256, 8192, gs, cs); \
                pg8::EpiBf16<0> E{(bf16_t*)(ws + WS_R4) + (size_t)2 * MT * 512, 512, 1, 0, 256}; \
                pg8::gemm_phase<pg8::EpiBf16<0>, pg8::StaticOrder, true, true>(F.lds, g, S, E); \
            } \
            if (PH(9)) REP(9) { GkW W; int hW = -1; for (int it = cs; it < NCH * 4; it += gs) { if ((it & 3) != hW) { hW = it & 3; gla_load_w(F, l, hW, W); } gla_pass1(F, l, it, W); } } \
        } \
        if (PH(10)) REP(10) conv_pass(F, l, F.bid, F.G); \
        GRID_SYNC(); REFRESH(); \
        if (PH(11)) REP(11) gla_scan(F, l); \
        GRID_SYNC(); REFRESH(); \
        if (PH(13)) REP(13) { \
            pg8::Gemm g{H, (const bf16_t*)(ws + WS_WMG), MT, NMG, DM}; pg8::StaticOrder S; S.init(MT, NMG, F.G, F.bid); \
            pg8::EpiBf16<2> E{(bf16_t*)(ws + WS_ZG), NMG, 0, 0, 0}; \
            pg8::gemm_phase<pg8::EpiBf16<2>, pg8::StaticOrder, true, true>(F.lds, g, S, E); \
        } \
        __syncthreads(); \
        if (PH(12)) REP(12) { GkW W; int hW = -1; for (int it = F.bid; it < NCH * 4; it += F.G) { if ((it & 3) != hW) { hW = it & 3; gla_load_w(F, l, hW, W); } gla_pass3(F, l, it, W); } } \
        GRID_SYNC(); REFRESH(); \
        if (PH(14)) REP(14) { \
            pg8::Gemm g{(const bf16_t*)(ws + WS_R4), (const bf16_t*)(ws + WS_WABC), 3 * MT, 3 * DM, 512}; pg8::BranchOrder S; S.init(F.G, F.bid); \
            pg8::EpiBranch E{(const bf16_t*)(ws + WS_ZG), (float*)(ws + WS_Z1), (bf16_t*)(ws + WS_YBF)}; \
            pg8::gemm_phase<pg8::EpiBranch, pg8::BranchOrder, true, true>(F.lds, g, S, E); \
        } \
        GRID_SYNC(); REFRESH(); \
        if (PH(15)) REP(15) { \
            pg8::Gemm g{(const bf16_t*)(ws + WS_YBF), (const bf16_t*)(ws + WS_WO), MT, DM, DM}; pg8::StaticOrder S; S.init(MT, DM, F.G, F.bid); \
            pg8::EpiRes E{F.out, mods_l + 2 * DM, RSC}; \
            pg8::gemm_phase<pg8::EpiRes, pg8::StaticOrder, true, true>(F.lds, g, S, E); \
        } \
        if (early && l < DEPTH - 1 && F.bid >= 64) { __syncthreads(); p1_cgen(F, false, F.bid - 64, F.G - 64); } \
        GRID_SYNC(); REFRESH(); \
        if (PH(16)) REP(16) norm_pass(F, 1, F.in[I_N2] + l * DM, mods_l, 3 * DM, 4 * DM, false); \
        GRID_SYNC(); REFRESH(); \
        if (PH(17)) REP(17) { \
            pg8::Gemm g{H, (const bf16_t*)(ws + WS_WUP), MT, 2 * DFF, DM}; pg8::StaticOrder S; S.init(MT, 2 * DFF, F.G, F.bid); \
            pg8::EpiSwiglu E{Z1}; \
            pg8::gemm_phase<pg8::EpiSwiglu, pg8::StaticOrder, true, true>(F.lds, g, S, E); \
        } \
        GRID_SYNC(); REFRESH(); \
        if (PH(18)) { \
            { pg8::Gemm g{Z1, (const bf16_t*)(ws + WS_WDN), MT, DM, DFF, 0}; pg8::LatOrder S; S.init(F.G, F.bid); \
              pg8::EpiRes E{F.out, mods_l + 5 * DM, RSC}; \
              pg8::gemm_phase<pg8::EpiRes, pg8::LatOrder, true, true>(F.lds, g, S, E); } \
            { pg8::Gemm g{Z1, (const bf16_t*)(ws + WS_WDN), MT, DM, DFF, DFF / 2}; pg8::CtxSplitOrder S; S.init(F.G, F.bid, DFF / 2); \
              pg8::EpiPart E{(bf16_t*)(ws + WS_XP), mods_l + 5 * DM}; \
              pg8::gemm_phase<pg8::EpiPart, pg8::CtxSplitOrder, true, true>(F.lds, g, S, E); } \
        } \
        if (early && l < DEPTH - 1 && F.bid < 128) { __syncthreads(); p1_fold(F, l + 1, F.bid, 128); } \
        GRID_SYNC(); REFRESH(); \
     \
    } while (0)
__global__ void __launch_bounds__(512, 2) fwd_megakernel(Args args) {
    extern __shared__ __attribute__((aligned(16))) unsigned char lds_raw[];
    cg::grid_group grid = cg::this_grid();
    Ctx F;
    F.lds = (LAS unsigned char*)lds_raw;
    F.tid = threadIdx.x; F.lane = F.tid & 63; F.wave = __builtin_amdgcn_readfirstlane(F.tid >> 6);
    F.G = gridDim.x; F.bid = blockIdx.x;
    unsigned char* ws; const float* mods; const float* mods_l; bf16_t* H; bf16_t* Z1; int l = 0;
    REFRESH();
    const int half = F.G >> 1;
    const bool early = F.G > 128;

#ifndef PHMASK
#define PHMASK 0xFFFFFF
#endif
#define PH(k) ((PHMASK >> (k)) & 1)
#ifndef RPMASK
#define RPMASK 0
#endif
#define RSC 1.0f
#define REP(k) for (int _rp = 0; _rp < 1 + ((RPMASK >> (k)) & 1); ++_rp)
    if (F.tid < 64) ((LAS unsigned*)(F.lds + 131072))[F.tid] = 0u;
    __syncthreads();
    if (F.tid == 0) (void)xb_add(&((unsigned*)(F.ws + WS_BAR))[XB_XCNT(xb_xcc_id())], 1u);
    if (PH(0)) p0_mods(F);
    CG_SYNC();

    l = 0; LAYER_BODY();
    l = 1; LAYER_BODY();
    l = 2; LAYER_BODY();
    l = 3; LAYER_BODY();
    l = 0; REFRESH();
    if (!PH(11)) { float* os = F.out + (size_t)MT * DM; for (int i = F.bid * 512 + F.tid; i < 4194304; i += F.G * 512) os[i] = 0.f; }
    if (PH(19)) norm_pass(F, 2, F.in[I_NF], mods, 0, 0, true);
}

extern "C" void kernel_launch(void* const* d_in, const int* in_sizes, int n_in, void* d_out, int out_size, void* d_ws, size_t ws_size, hipStream_t stream) {
    static int grid = 0;
    if (grid == 0) {
        if (n_in != 23 || ws_size < WS_END) { fprintf(stderr, "kernel_launch: unexpected n_in %d / ws_size %zu (need %zu)\n", n_in, ws_size, (size_t)WS_END); grid = -1; return; }
        int dev = 0, cus = 0, per_cu = 0;
        hipGetDevice(&dev);
        hipDeviceGetAttribute(&cus, hipDeviceAttributeMultiprocessorCount, dev);
        hipFuncSetAttribute((const void*)fwd_megakernel, hipFuncAttributeMaxDynamicSharedMemorySize, LDS_BYTES);
        hipOccupancyMaxActiveBlocksPerMultiprocessor(&per_cu, (const void*)fwd_megakernel, 512, LDS_BYTES);
        (void)hipGetLastError();
        if (per_cu < 1) per_cu = 1;
        grid = cus;
    }
    if (grid < 0) return;
    (void)hipMemsetAsync((char*)d_ws + WS_BAR, 0, 16384, stream);
    Args a{};
    for (int i = 0; i < 23; ++i) a.in[i] = (const float*)d_in[i];
    a.out = (float*)d_out; a.ws = (unsigned char*)d_ws;
    void* params[] = {&a};
    hipError_t e = hipLaunchCooperativeKernel((const void*)fwd_megakernel, dim3(grid), dim3(512), params, LDS_BYTES, stream);
    if (e != hipSuccess) fprintf(stderr, "cooperative launch failed: %s (grid %d)\n", hipGetErrorString(e), grid);
}
```

```cpp
#include <hip/hip_runtime.h>
#include <hip/hip_cooperative_groups.h>
#include <cstdio>
#include <cstdint>
namespace cg = cooperative_groups;

#define GAS __attribute__((address_space(1)))
#define LAS __attribute__((address_space(3)))
typedef unsigned short bf16_t;
typedef short bf16x8 __attribute__((ext_vector_type(8)));
typedef float f32x4 __attribute__((ext_vector_type(4)));
typedef float f32x2 __attribute__((ext_vector_type(2)));
typedef unsigned u32x4 __attribute__((ext_vector_type(4)));
typedef unsigned u32x2 __attribute__((ext_vector_type(2)));

constexpr int DM = 1024, NCTX = 4096, MT = 20480, PIN = 6688, NMOD = 6144, DFF = 2816, DEPTH = 4;
constexpr int NZ1 = 3072, NZA = 1536, NPT = 1280, NMG = 3072, NCH = 320;
constexpr float EPS = 1e-6f;
constexpr size_t MiB = 1u << 20;
constexpr size_t WS_MODS = 0, WS_T4096 = 512 * 1024, WS_C256 = 1 * MiB, WS_GG = 2 * MiB, WS_GKT = 4 * MiB;
constexpr size_t WS_WIN = 6 * MiB, WS_WPT = 12 * MiB, WS_WMG = 15 * MiB, WS_WABC = 21 * MiB, WS_WO = 24 * MiB, WS_WUP = 26 * MiB, WS_WDN = 37 * MiB;
constexpr size_t WS_H = 43 * MiB, WS_Z1 = 83 * MiB, WS_Z1B = 143 * MiB, WS_SS = 203 * MiB, WS_YBF = 203 * MiB, WS_PT = 243 * MiB, WS_C = 283 * MiB, WS_ZG = 243 * MiB, WS_US = 347 * MiB, WS_R4 = 367 * MiB, WS_XP = 427 * MiB, WS_END = 443 * MiB;
constexpr int LDS_BYTES = 147456, LDS_MISC = 131072 + 64;
constexpr size_t WS_BAR = 3 * MiB, WS_PT2 = 315 * MiB;

typedef __bf16 bf16x2_t __attribute__((ext_vector_type(2)));
__device__ __forceinline__ unsigned cvt_pk_bf16(float lo, float hi) { const f32x2 v = {lo, hi}; const bf16x2_t b = __builtin_convertvector(v, bf16x2_t); return __builtin_bit_cast(unsigned, b); }
__device__ __forceinline__ float bf2f(unsigned short x) { return __uint_as_float(((unsigned)x) << 16); }
__device__ __forceinline__ float bflo(unsigned w) { return __uint_as_float(w << 16); }
__device__ __forceinline__ float bfhi(unsigned w) { return __uint_as_float(w & 0xffff0000u); }
__device__ __forceinline__ float sigmoidf_(float x) { return 1.0f / (1.0f + __expf(-x)); }
__device__ __forceinline__ float siluf_(float x) { return x / (1.0f + __expf(-x)); }
__device__ __forceinline__ float logsigf_(float x) { return fminf(x, 0.0f) - __logf(1.0f + __expf(-fabsf(x))); }
__device__ __forceinline__ float fin_(float v) { return v; }
__device__ __forceinline__ float wave_sum(float v) {
#pragma unroll
    for (int o = 1; o < 64; o <<= 1) v += __shfl_xor(v, o);
    return v;
}

namespace pg8 {
constexpr int BM = 256, BK = 64, HALF = 128, HTB = HALF * BK * 2, STAGE_BYTES = 8 * HTB, NXCD = 8, WGM = 8;
__host__ __device__ __forceinline__ int lds_byte(int r, int c) { const int st = (r >> 4) * 2 + (c >> 5), rr = r & 15, cc = c & 31, ob = rr * 64 + cc * 2; return st * 1024 + (ob ^ (((ob >> 9) & 1) << 5)); }
__host__ __device__ __forceinline__ void stage_rc(int b, int& R, int& C) { const int st = b / 1024, sb = b % 1024, swz = sb ^ (((sb >> 9) & 1) << 5); R = (st >> 1) * 16 + swz / 64; C = (st & 1) * 32 + (swz % 64) / 2; }
__host__ __device__ __forceinline__ int perm32(int rho) { const int n = rho >> 4, i = rho & 15; return 8 * (i >> 2) + 4 * n + (i & 3); }

struct Unit { int pm, pn, koff, ks; };
struct Gemm { const bf16_t* A; const bf16_t* Bt; int M, N, K; int Kl; };

struct StaticOrder {
    int nM, nN, nwg, G, c;
    __device__ void init(int M, int N, int G_, int c_) { nM = M / BM; nN = N / BM; nwg = nM * nN; G = G_; c = c_; }
    __device__ __forceinline__ void map(int L, Unit& u) const {
        int wgid = L; { const int q = nwg / NXCD, r = nwg % NXCD, xcd = wgid % NXCD, off = wgid / NXCD; wgid = (xcd < r ? xcd * (q + 1) : r * (q + 1) + (xcd - r) * q) + off; }
        const int nig = WGM * nN, gid = wgid / nig, fm = gid * WGM, gsz = (nM - fm) < WGM ? (nM - fm) : WGM;
        u.pm = fm + ((wgid % nig) % gsz); u.pn = (wgid % nig) / gsz; u.koff = 0; u.ks = 0;
    }
    __device__ bool next(int i, Unit& u) const {
        const long L = (long)i * G + c; if (L >= nwg) return false;
        map((int)L, u); return true;
    }
};
struct BranchOrder {
    StaticOrder so;
    __device__ void init(int G_, int c_) { so.init(MT, DM, G_, c_); }
    __device__ bool next(int i, Unit& u) const {
        const int T = i / 3, br = i - 3 * T;
        const long L = (long)T * so.G + so.c; if (L >= so.nwg) return false;
        so.map((int)L, u); u.pm += br * (MT / BM); u.pn += br * (DM / BM); return true;
    }
};

struct LatOrder {
    StaticOrder so;
    __device__ void init(int G_, int c_) { so.init(MT - NCTX, DM, G_, c_); }
    __device__ bool next(int i, Unit& u) const { if (!so.next(i, u)) return false; u.pm += NCTX / BM; return true; }
};
struct CtxSplitOrder {
    int G, c, Kl;
    __device__ void init(int G_, int c_, int Kl_) { G = G_; c = c_; Kl = Kl_; }
    __device__ bool next(int i, Unit& u) const {
        int idx;
        if (G >= 128) { if (i > 0) return false; idx = c - (G - 128); if (idx < 0) return false; }
        else { idx = i * G + c; if (idx >= 128) return false; }
        u.ks = idx >> 6; const int t = idx & 63; u.pm = t >> 2; u.pn = t & 3; u.koff = u.ks * Kl; return true;
    }
};

#define PG8_ACC const f32x4 (&acc)[2][2][4][2]
__device__ __forceinline__ u32x4 pack8(f32x4 v0, f32x4 v1) { u32x4 w; w.x = cvt_pk_bf16(v0[0], v0[1]); w.y = cvt_pk_bf16(v0[2], v0[3]); w.z = cvt_pk_bf16(v1[0], v1[1]); w.w = cvt_pk_bf16(v1[2], v1[3]); return w; }

template <int ACT> struct EpiBf16 {
    static constexpr bool PERM = true, AFTER_DRAIN = false;
    bf16_t* O; int ldc; int mode; int R0, L;
    __device__ __forceinline__ void operator()(PG8_ACC, const Unit& u, int wr, int wc, int fr, int fq) const {
        int rb = u.pm * BM, cb = u.pn * BM;
        if (mode == 1) { rb = R0 + (u.pn >> 1) * L + u.pm * BM; cb = (u.pn & 1) * BM; }
        bf16_t* Ob = O;
        if (mode == 2 && u.pn >= 6) { cb -= 6 * BM; Ob = O + (size_t)MT * NZA; }
        const int row0 = rb + wr * 64 + fr, col0 = cb + wc * 32 + 8 * fq;
#pragma unroll
        for (int ai = 0; ai < 2; ++ai)
#pragma unroll
            for (int m = 0; m < 4; ++m) { bf16_t* rowp = Ob + (size_t)(row0 + ai * HALF + m * 16) * ldc + col0;
#pragma unroll
                for (int bj = 0; bj < 2; ++bj) { f32x4 v0 = acc[ai][bj][m][0], v1 = acc[ai][bj][m][1];
                    if (ACT == 2) {
#pragma unroll
                        for (int j = 0; j < 4; ++j) { v0[j] = sigmoidf_(v0[j]); v1[j] = sigmoidf_(v1[j]); } }
                    *(u32x4*)(rowp + bj * HALF) = pack8(v0, v1); } }
    }
};
struct EpiPT {
    static constexpr bool PERM = true, AFTER_DRAIN = false;
    bf16_t* PTc; bf16_t* PTl; bf16_t* GKT;
    __device__ __forceinline__ void operator()(PG8_ACC, const Unit& u, int wr, int wc, int fr, int fq) const {
        const int ct0 = wc * 32 + 8 * fq;
        if (u.pm < 4) {
            const int s = u.pm >> 1, chb = (u.pm & 1) * 256;
            bf16_t* base; size_t rstride;
            if (u.pn < 16) { base = PTc + (size_t)u.pn * 512 * 512 + s * 256; rstride = 512; }
            else { const int q = u.pn - 16; base = PTl + (size_t)(q >> 4) * 512 * 8192 + s * 4096 + (q & 15) * 256; rstride = 8192; }
#pragma unroll
            for (int ai = 0; ai < 2; ++ai)
#pragma unroll
                for (int m = 0; m < 4; ++m) { const int ch = chb + ai * HALF + wr * 64 + m * 16 + fr; bf16_t* rowp = base + (size_t)ch * rstride + ct0;
#pragma unroll
                    for (int bj = 0; bj < 2; ++bj) *(u32x4*)(rowp + bj * HALF) = pack8(acc[ai][bj][m][0], acc[ai][bj][m][1]); }
        } else if (wr == 0) {
#pragma unroll
            for (int m = 0; m < 2; ++m) { const int r = m * 16 + fr; bf16_t* rowp = GKT + (size_t)r * MT + u.pn * BM + ct0;
#pragma unroll
                for (int bj = 0; bj < 2; ++bj) *(u32x4*)(rowp + bj * HALF) = pack8(acc[0][bj][m][0], acc[0][bj][m][1]); }
        }
    }
};
struct EpiBranch {
    static constexpr bool PERM = true, AFTER_DRAIN = false;
    const bf16_t* ZG; float* yacc; bf16_t* ybf;
    __device__ __forceinline__ void operator()(PG8_ACC, const Unit& u, int wr, int wc, int fr, int fq) const {
        const int br = u.pn >> 2, pn = u.pn & 3, pm = u.pm - br * (MT / BM);
        const int row0 = pm * BM + wr * 64 + fr, col0 = pn * BM + wc * 32 + 8 * fq;
#pragma unroll
        for (int ai = 0; ai < 2; ++ai)
#pragma unroll
            for (int mp = 0; mp < 2; ++mp) {
                u32x4 gq[2][2]; f32x4 yin[2][2][2];
#pragma unroll
                for (int mm = 0; mm < 2; ++mm)
#pragma unroll
                    for (int bj = 0; bj < 2; ++bj) { const size_t row = (size_t)(row0 + ai * HALF + (2 * mp + mm) * 16); const int col = col0 + bj * HALF;
                        gq[mm][bj] = *(const u32x4*)(ZG + row * NMG + br * DM + col);
                        if (br != 0) { const float* yp = yacc + row * DM + col; yin[mm][bj][0] = *(const f32x4*)yp; yin[mm][bj][1] = *(const f32x4*)(yp + 4); } }
                asm volatile("" ::: "memory");
#pragma unroll
                for (int mm = 0; mm < 2; ++mm)
#pragma unroll
                    for (int bj = 0; bj < 2; ++bj) { const int m = 2 * mp + mm; const size_t row = (size_t)(row0 + ai * HALF + m * 16); const int col = col0 + bj * HALF;
                        const u32x4 g = gq[mm][bj];
                        f32x4 v0 = acc[ai][bj][m][0], v1 = acc[ai][bj][m][1];
                        v0[0] *= bflo(g.x); v0[1] *= bfhi(g.x); v0[2] *= bflo(g.y); v0[3] *= bfhi(g.y);
                        v1[0] *= bflo(g.z); v1[1] *= bfhi(g.z); v1[2] *= bflo(g.w); v1[3] *= bfhi(g.w);
                        float* yp = yacc + row * DM + col;
                        if (br != 0) { v0 += yin[mm][bj][0]; v1 += yin[mm][bj][1]; }
                        if (br != 2) { *(f32x4*)yp = v0; *(f32x4*)(yp + 4) = v1; }
                        else *(u32x4*)(ybf + row * DM + col) = pack8(v0, v1); }
                asm volatile("" ::: "memory");
            }
    }
};
struct EpiRes {
    static constexpr bool PERM = false, AFTER_DRAIN = false;
    float* x; const float* gate; float rsc;
    __device__ __forceinline__ void operator()(PG8_ACC, const Unit& u, int wr, int wc, int fr, int fq) const {
        const int cond = u.pm < 16 ? 0 : 1 + ((u.pm - 16) >> 4);
        const int col0 = u.pn * BM + wc * 32 + 4 * fq;
        const float* gp = gate + (size_t)cond * NMOD + col0;
        f32x4 gv[2][2];
#pragma unroll
        for (int bj = 0; bj < 2; ++bj)
#pragma unroll
            for (int n = 0; n < 2; ++n) gv[bj][n] = *(const f32x4*)(gp + bj * HALF + n * 16) * rsc;
#pragma unroll
        for (int ai = 0; ai < 2; ++ai) {
            float* rowb = x + (size_t)(u.pm * BM + ai * HALF + wr * 64 + fr) * DM + col0;
            f32x4 xin[4][2][2];
#pragma unroll
            for (int m = 0; m < 4; ++m)
#pragma unroll
                for (int bj = 0; bj < 2; ++bj)
#pragma unroll
                    for (int n = 0; n < 2; ++n) xin[m][bj][n] = *(const f32x4*)(rowb + (size_t)m * 16 * DM + bj * HALF + n * 16);
            asm volatile("" ::: "memory");
#pragma unroll
            for (int m = 0; m < 4; ++m)
#pragma unroll
                for (int bj = 0; bj < 2; ++bj)
#pragma unroll
                    for (int n = 0; n < 2; ++n) *(f32x4*)(rowb + (size_t)m * 16 * DM + bj * HALF + n * 16) = xin[m][bj][n] + gv[bj][n] * acc[ai][bj][m][n];
            asm volatile("" ::: "memory");
        }
    }
};
struct EpiPart {
    static constexpr bool PERM = true, AFTER_DRAIN = false;
    bf16_t* XP; const float* gate;
    __device__ __forceinline__ void operator()(PG8_ACC, const Unit& u, int wr, int wc, int fr, int fq) const {
        const int row0 = u.pm * BM + wr * 64 + fr, col0 = u.pn * BM + wc * 32 + 8 * fq;
        f32x4 gv[2][2];
#pragma unroll
        for (int bj = 0; bj < 2; ++bj)
#pragma unroll
            for (int n = 0; n < 2; ++n) gv[bj][n] = *(const f32x4*)(gate + col0 + bj * HALF + 4 * n);
        bf16_t* base = XP + (size_t)u.ks * NCTX * DM;
#pragma unroll
        for (int ai = 0; ai < 2; ++ai)
#pragma unroll
            for (int m = 0; m < 4; ++m) { bf16_t* rowp = base + (size_t)(row0 + ai * HALF + m * 16) * DM + col0;
#pragma unroll
                for (int bj = 0; bj < 2; ++bj) *(u32x4*)(rowp + bj * HALF) = pack8(acc[ai][bj][m][0] * gv[bj][0], acc[ai][bj][m][1] * gv[bj][1]); }
    }
};
struct EpiSwiglu {
    static constexpr bool PERM = true, AFTER_DRAIN = false;
    bf16_t* FF;
    __device__ __forceinline__ void operator()(PG8_ACC, const Unit& u, int wr, int wc, int fr, int fq) const {
        const int row0 = u.pm * BM + wr * 64 + fr, col0 = u.pn * HALF + wc * 32 + 8 * fq;
#pragma unroll
        for (int ai = 0; ai < 2; ++ai)
#pragma unroll
            for (int m = 0; m < 4; ++m) { f32x4 v0, v1;
#pragma unroll
                for (int j = 0; j < 4; ++j) { v0[j] = siluf_(acc[ai][0][m][0][j]) * acc[ai][1][m][0][j]; v1[j] = siluf_(acc[ai][0][m][1][j]) * acc[ai][1][m][1][j]; }
                *(u32x4*)(FF + (size_t)(row0 + ai * HALF + m * 16) * DFF + col0) = pack8(v0, v1); }
    }
};

template <class Epi, class Sched, bool ALIGN_EPI = false, bool SP2 = false>
__device__ __forceinline__ void gemm_phase(LAS unsigned char* lds, const Gemm g, const Sched& S, const Epi& E) {
    int tid_ = threadIdx.x; asm volatile("" : "+v"(tid_));
    const int tid = tid_, wid = __builtin_amdgcn_readfirstlane(tid >> 6), lane = tid & 63, wr = wid >> 2, wc = wid & 3, fr = lane & 15, fq = lane >> 4;
    const int K = g.K, nt = (g.Kl ? g.Kl : g.K) / BK;
    unsigned voffA[2], voffB[2];
#pragma unroll
    for (int i = 0; i < 2; ++i) { int R, C; stage_rc(tid * 16 + i * 8192, R, C); const int Rb = Epi::PERM ? ((R & ~31) + perm32(R & 31)) : R;
        voffA[i] = (unsigned)(R * K + C) * 2u; voffB[i] = (unsigned)(Rb * K + C) * 2u; }
    const size_t kstep = (size_t)(BK * 2);
    const size_t hstep = (size_t)HALF * K * 2;
    const size_t tstep = 2 * hstep;
    const unsigned ldsw = (unsigned)wid * 1024u;
    const int aoff = lds_byte(wr * 64 + fr, fq * 8), boff = lds_byte(wc * 32 + fr, fq * 8);
#define PG8_SA(b, h) (((b) * 2 + (h)) * HTB)
#define PG8_SB(b, h) ((4 + (b) * 2 + (h)) * HTB)
#define PG8_STAGE(bufoff, gbase, voff) do { _Pragma("unroll") for (int _i = 0; _i < 2; ++_i) \
        __builtin_amdgcn_global_load_lds((const unsigned*)((const char*)(gbase) + (voff)[_i]), (LAS unsigned*)(lds + (bufoff) + ldsw + _i * 8192), 16, 0, 0); } while (0)
#define PG8_LDA(dst, b, h) do { _Pragma("unroll") for (int m = 0; m < 4; ++m) _Pragma("unroll") for (int k = 0; k < 2; ++k) dst[m][k] = *(const LAS bf16x8*)(lds + PG8_SA(b, h) + aoff + m * 2048 + k * 1024); } while (0)
#define PG8_LDB(dst, b, h) do { _Pragma("unroll") for (int n = 0; n < 2; ++n) _Pragma("unroll") for (int k = 0; k < 2; ++k) dst[n][k] = *(const LAS bf16x8*)(lds + PG8_SB(b, h) + boff + n * 2048 + k * 1024); } while (0)
#define PG8_MMA(ai, bj, At, Bt) do { __builtin_amdgcn_s_setprio(1); _Pragma("unroll") for (int m = 0; m < 4; ++m) _Pragma("unroll") for (int n = 0; n < 2; ++n) _Pragma("unroll") for (int k = 0; k < 2; ++k) \
        acc[ai][bj][m][n] = __builtin_amdgcn_mfma_f32_16x16x32_bf16(Bt[n][k], At[m][k], acc[ai][bj][m][n], 0, 0, 0); __builtin_amdgcn_s_setprio(0); } while (0)
#define PG8_WAIT_V(n) asm volatile("s_waitcnt vmcnt(" #n ")" ::: "memory")
#define PG8_WAIT_L(n) asm volatile("s_waitcnt lgkmcnt(" #n ")" ::: "memory")
#define PG8_BAR __builtin_amdgcn_s_barrier()
#define PG8_SCHED __builtin_amdgcn_sched_barrier(0)
    Unit cur, nxt; int ui = 0;
    if (!S.next(0, cur)) return;
    f32x4 acc[2][2][4][2];
#pragma unroll
    for (int a = 0; a < 2; ++a)
#pragma unroll
        for (int b = 0; b < 2; ++b)
#pragma unroll
            for (int m = 0; m < 4; ++m)
#pragma unroll
                for (int n = 0; n < 2; ++n) acc[a][b][m][n] = (f32x4){0.f, 0.f, 0.f, 0.f};
    bf16x8 At[4][2], B0[2][2], B1[2][2];
    const char* cA = (const char*)g.A + (size_t)cur.pm * tstep + (size_t)cur.koff * 2; const char* cB = (const char*)g.Bt + (size_t)cur.pn * tstep + (size_t)cur.koff * 2;
    if constexpr (SP2) {
        PG8_STAGE(PG8_SB(0, 0), cB, voffB); PG8_STAGE(PG8_SB(0, 1), cB + hstep, voffB); PG8_STAGE(PG8_SA(0, 0), cA, voffA); PG8_STAGE(PG8_SA(0, 1), cA + hstep, voffA);
        if (wr == 1) PG8_BAR;
        PG8_WAIT_V(2); PG8_BAR;
        PG8_STAGE(PG8_SB(1, 0), cB + kstep, voffB); PG8_STAGE(PG8_SA(1, 0), cA + kstep, voffA); PG8_STAGE(PG8_SB(1, 1), cB + hstep + kstep, voffB);
        PG8_WAIT_V(6); PG8_BAR;
    } else {
        PG8_STAGE(PG8_SB(0, 0), cB, voffB); PG8_STAGE(PG8_SA(0, 0), cA, voffA); PG8_STAGE(PG8_SB(0, 1), cB + hstep, voffB); PG8_STAGE(PG8_SA(0, 1), cA + hstep, voffA);
        if (wr == 1) PG8_BAR;
        PG8_WAIT_V(4); PG8_BAR;
        PG8_STAGE(PG8_SB(1, 0), cB + kstep, voffB); PG8_STAGE(PG8_SA(1, 0), cA + kstep, voffA); PG8_STAGE(PG8_SB(1, 1), cB + hstep + kstep, voffB);
        PG8_WAIT_V(6); PG8_BAR;
    }
    for (;;) {
        const bool has_next = S.next(ui + 1, nxt);
        const char* nA = has_next ? (const char*)g.A + (size_t)nxt.pm * tstep + (size_t)nxt.koff * 2 : cA; const char* nB = has_next ? (const char*)g.Bt + (size_t)nxt.pn * tstep + (size_t)nxt.koff * 2 : cB;
        for (int t = 0; t < nt; t += 2) {
            const bool last = (t == nt - 2);
            const char* a1 = cA + (size_t)(t + 1) * kstep;
            const char* a2 = last ? nA : cA + (size_t)(t + 2) * kstep; const char* b2 = last ? nB : cB + (size_t)(t + 2) * kstep;
            const char* a3 = a2 + kstep; const char* b3 = b2 + kstep;
            if constexpr (SP2) {
            PG8_LDB(B0, 0, 0); PG8_LDB(B1, 0, 1); PG8_SCHED; PG8_LDA(At, 0, 0); PG8_STAGE(PG8_SA(1, 1), a1 + hstep, voffA);
            PG8_WAIT_V(8); PG8_WAIT_L(0); PG8_BAR; PG8_MMA(0, 0, At, B0); PG8_MMA(0, 1, At, B1); PG8_BAR; PG8_SCHED;
            PG8_LDA(At, 0, 1); PG8_STAGE(PG8_SB(0, 0), b2, voffB); PG8_STAGE(PG8_SB(0, 1), b2 + hstep, voffB); PG8_STAGE(PG8_SA(0, 0), a2, voffA);
            PG8_WAIT_V(8); PG8_WAIT_L(0); PG8_BAR; PG8_MMA(1, 0, At, B0); PG8_MMA(1, 1, At, B1); PG8_BAR; PG8_SCHED;
            PG8_LDB(B0, 1, 0); PG8_LDB(B1, 1, 1); PG8_SCHED; PG8_LDA(At, 1, 0); PG8_STAGE(PG8_SA(0, 1), a2 + hstep, voffA);
            PG8_WAIT_V(8); PG8_WAIT_L(0); PG8_BAR; PG8_MMA(0, 0, At, B0); PG8_MMA(0, 1, At, B1); PG8_BAR; PG8_SCHED;
            PG8_LDA(At, 1, 1); PG8_STAGE(PG8_SB(1, 0), b3, voffB); PG8_STAGE(PG8_SB(1, 1), b3 + hstep, voffB); PG8_STAGE(PG8_SA(1, 0), a3, voffA);
            PG8_WAIT_V(8); PG8_WAIT_L(0); PG8_BAR; PG8_MMA(1, 0, At, B0); PG8_MMA(1, 1, At, B1); PG8_BAR; PG8_SCHED;
            } else {
            PG8_LDB(B0, 0, 0); PG8_SCHED; PG8_LDA(At, 0, 0); PG8_STAGE(PG8_SA(1, 1), a1 + hstep, voffA);
            PG8_WAIT_L(8); PG8_BAR; PG8_WAIT_L(0); PG8_MMA(0, 0, At, B0); PG8_BAR; PG8_SCHED;
            PG8_LDB(B1, 0, 1); PG8_STAGE(PG8_SB(0, 0), b2, voffB);
            PG8_BAR; PG8_WAIT_L(0); PG8_MMA(0, 1, At, B1); PG8_BAR;
            PG8_LDA(At, 0, 1); PG8_STAGE(PG8_SA(0, 0), a2, voffA);
            PG8_BAR; PG8_WAIT_L(0); PG8_MMA(1, 0, At, B0); PG8_BAR; PG8_SCHED;
            PG8_STAGE(PG8_SB(0, 1), b2 + hstep, voffB);
            PG8_WAIT_V(6); PG8_BAR; PG8_MMA(1, 1, At, B1); PG8_BAR;
            PG8_LDB(B0, 1, 0); PG8_SCHED; PG8_LDA(At, 1, 0); PG8_STAGE(PG8_SA(0, 1), a2 + hstep, voffA);
            PG8_WAIT_L(8); PG8_BAR; PG8_WAIT_L(0); PG8_MMA(0, 0, At, B0); PG8_BAR; PG8_SCHED;
            PG8_LDB(B1, 1, 1); PG8_STAGE(PG8_SB(1, 0), b3, voffB);
            PG8_BAR; PG8_WAIT_L(0); PG8_MMA(0, 1, At, B1); PG8_BAR;
            PG8_LDA(At, 1, 1); PG8_STAGE(PG8_SA(1, 0), a3, voffA);
            PG8_BAR; PG8_WAIT_L(0); PG8_MMA(1, 0, At, B0); PG8_BAR; PG8_SCHED;
            PG8_STAGE(PG8_SB(1, 1), b3 + hstep, voffB);
            PG8_WAIT_V(6); PG8_BAR; PG8_MMA(1, 1, At, B1); PG8_BAR;
            }
        }
        if constexpr (ALIGN_EPI) { if (wr == 0) PG8_BAR; }
        E(acc, cur, wr, wc, fr, fq);
        if (!has_next) break;
#pragma unroll
        for (int a = 0; a < 2; ++a)
#pragma unroll
            for (int b = 0; b < 2; ++b)
#pragma unroll
                for (int m = 0; m < 4; ++m)
#pragma unroll
                    for (int n = 0; n < 2; ++n) acc[a][b][m][n] = (f32x4){0.f, 0.f, 0.f, 0.f};
        cur = nxt; cA = nA; cB = nB; ++ui;
        if constexpr (ALIGN_EPI) { if (wr == 1) PG8_BAR; }
    }
    PG8_WAIT_V(0);
    if constexpr (!ALIGN_EPI) { if (wr == 0) PG8_BAR; }
    PG8_BAR;
#undef PG8_SA
#undef PG8_SB
#undef PG8_STAGE
#undef PG8_LDA
#undef PG8_LDB
#undef PG8_MMA
#undef PG8_WAIT_V
#undef PG8_WAIT_L
#undef PG8_BAR
#undef PG8_SCHED
}
}

struct Args { const float* in[23]; float* out; unsigned char* ws; };
enum { I_XP = 0, I_XS, I_STATE, I_C, I_CCTX, I_WADA, I_BADA, I_N1, I_N2, I_WIN, I_WGKF, I_BGKF, I_WGKB, I_BGKB, I_GLAN, I_WA, I_CONVW, I_WB, I_WC, I_WO, I_WUP, I_WDN, I_NF };

struct Ctx {
    LAS unsigned char* lds;
    int tid, lane, wave, G, bid;
    const float* const* in; float* out; unsigned char* ws;
};
__device__ __forceinline__ const Args* args_fresh() { const Args* p = (const Args*)__builtin_amdgcn_kernarg_segment_ptr(); asm volatile("" : "+s"(p)); return p; }
#define REFRESH() do { { int _t = threadIdx.x; asm volatile("" : "+v"(_t)); F.tid = _t; F.lane = _t & 63; F.wave = __builtin_amdgcn_readfirstlane(_t >> 6); } const Args* _a = args_fresh(); F.in = _a->in; F.out = _a->out; F.ws = _a->ws; ws = F.ws; mods = (const float*)(ws + WS_MODS); H = (bf16_t*)(ws + WS_H); Z1 = (bf16_t*)(ws + WS_Z1); mods_l = mods + (size_t)l * 5 * NMOD; } while (0)


__device__ __forceinline__ void p0_mods(const Ctx& F) {
    LAS float* sc = (LAS float*)F.lds;
    LAS float* part = (LAS float*)(F.lds + 20480);
    for (int i = F.tid; i < 5 * DM; i += 512) { const int c = i >> 10, k = i & 1023; const float v = c == 0 ? F.in[I_CCTX][k] : F.in[I_C][(c - 1) * DM + k]; sc[i] = siluf_(v); }
    __syncthreads();
    float* mods = (float*)(F.ws + WS_MODS);
    for (int item = F.bid; item < DEPTH * 96; item += F.G) {
        const int l = item / 96, jb = item % 96;
        const float* w = F.in[I_WADA] + (size_t)l * DM * NMOD + jb * 64 + F.lane;
        float a0 = 0.f, a1 = 0.f, a2 = 0.f, a3 = 0.f, a4 = 0.f;
        const int k0 = F.wave * 128;
#pragma unroll 32
        for (int k = 0; k < 128; ++k) { const float wv = w[(size_t)(k0 + k) * NMOD];
            a0 += sc[k0 + k] * wv; a1 += sc[1024 + k0 + k] * wv; a2 += sc[2048 + k0 + k] * wv; a3 += sc[3072 + k0 + k] * wv; a4 += sc[4096 + k0 + k] * wv; }
        part[(F.wave * 5 + 0) * 64 + F.lane] = a0; part[(F.wave * 5 + 1) * 64 + F.lane] = a1; part[(F.wave * 5 + 2) * 64 + F.lane] = a2;
        part[(F.wave * 5 + 3) * 64 + F.lane] = a3; part[(F.wave * 5 + 4) * 64 + F.lane] = a4;
        __syncthreads();
        if (F.tid < 320) { const int c = F.tid >> 6, j = F.tid & 63; float s = F.in[I_BADA][l * NMOD + jb * 64 + j];
#pragma unroll
            for (int w8 = 0; w8 < 8; ++w8) s += part[(w8 * 5 + c) * 64 + j];
            mods[(size_t)(l * 5 + c) * NMOD + jb * 64 + j] = s; }
        __syncthreads();
    }
    float* T = (float*)(F.ws + WS_T4096);
    for (int j = F.bid * 512 + F.tid; j < 4096; j += F.G * 512) T[j] = cospif((float)j * (1.0f / 2048.0f));
    { u32x4* z = (u32x4*)((bf16_t*)(F.ws + WS_WPT) + (size_t)1056 * DM); const int n16 = 224 * DM * 2 / 16;
      for (int i = F.bid * 512 + F.tid; i < n16; i += F.G * 512) z[i] = (u32x4){0u, 0u, 0u, 0u}; }
}

__device__ __forceinline__ void transpose_item(const float* W, int ldw, int K, int c0, bf16_t* WT, int r0, int k0, LAS float* scr, int lane) {
#pragma unroll 8
    for (int i = 0; i < 32; ++i) { const int kk = 2 * i + (lane >> 5); scr[kk * 33 + (lane & 31)] = W[(size_t)(k0 + kk) * ldw + c0 + (lane & 31)]; }
    asm volatile("s_waitcnt lgkmcnt(0)" ::: "memory");
    const int c = lane & 7;
#pragma unroll
    for (int j = 0; j < 4; ++j) { const int n = (lane >> 3) + 8 * j; const LAS float* s = scr + (8 * c) * 33 + n;
        u32x4 o; o.x = cvt_pk_bf16(s[0 * 33], s[1 * 33]); o.y = cvt_pk_bf16(s[2 * 33], s[3 * 33]); o.z = cvt_pk_bf16(s[4 * 33], s[5 * 33]); o.w = cvt_pk_bf16(s[6 * 33], s[7 * 33]);
        *(u32x4*)(WT + (size_t)(r0 + n) * K + k0 + 8 * c) = o; }
    asm volatile("s_waitcnt lgkmcnt(0)" ::: "memory");
}
__device__ __forceinline__ void p1_convert(const Ctx& F, int l, int part, int cs, int gs) {
    LAS float* scr = (LAS float*)(F.lds + F.wave * 8448);
    const int gw = cs * 8 + F.wave, NGW = gs * 8;
    constexpr int I_IN = 16 * 96, I_GK = 16, I_MG = 16 * 96, I_ABC = 8 * 32, I_O = 16 * 32, I_UP = 16 * 176, I_DN = 44 * 32;
    constexpr int NITEMS = I_IN + I_GK + I_MG + 3 * I_ABC + I_O + I_UP + I_DN;
    const float* win = F.in[I_WIN] + (size_t)l * DM * PIN;
    const int it_lo = part == 2 ? NITEMS - I_DN : 0, it_hi = part == 1 ? NITEMS - I_DN : NITEMS;
    for (int it = it_lo + gw; it < it_hi; it += NGW) {
        int r = it;
        if (r < I_IN) { const int kb = r / 96, nb = r % 96, r0 = nb * 32; transpose_item(win, PIN, DM, r0 < 1536 ? r0 : r0 + 32, (bf16_t*)(F.ws + WS_WIN), r0, kb * 64, scr, F.lane); continue; } r -= I_IN;
        if (r < I_GK) { transpose_item(win, PIN, DM, 1536, (bf16_t*)(F.ws + WS_WPT), 1024, r * 64, scr, F.lane); continue; } r -= I_GK;
        if (r < I_MG) { const int kb = r / 96, nb = r % 96; transpose_item(win, PIN, DM, 3616 + nb * 32, (bf16_t*)(F.ws + WS_WMG), nb * 32, kb * 64, scr, F.lane); continue; } r -= I_MG;
        if (r < 3 * I_ABC) { const int br = r / I_ABC, q = r % I_ABC, kb = q / 32, nb = q % 32; const float* w = F.in[br == 0 ? I_WA : (br == 1 ? I_WB : I_WC)] + (size_t)l * 512 * DM;
            transpose_item(w, DM, 512, nb * 32, (bf16_t*)(F.ws + WS_WABC) + (size_t)br * DM * 512, nb * 32, kb * 64, scr, F.lane); continue; } r -= 3 * I_ABC;
        if (r < I_O) { const int kb = r / 32, nb = r % 32; transpose_item(F.in[I_WO] + (size_t)l * DM * DM, DM, DM, nb * 32, (bf16_t*)(F.ws + WS_WO), nb * 32, kb * 64, scr, F.lane); continue; } r -= I_O;
        if (r < I_UP) { const int kb = r / 176, nb = r % 176, r0 = nb * 32, t = r0 >> 8, w = r0 & 255; const int c0 = w < 128 ? t * 128 + w : DFF + t * 128 + (w - 128);
            transpose_item(F.in[I_WUP] + (size_t)l * DM * 2 * DFF, 2 * DFF, DM, c0, (bf16_t*)(F.ws + WS_WUP), r0, kb * 64, scr, F.lane); continue; } r -= I_UP;
        { const int kb = r / 32, nb = r % 32; transpose_item(F.in[I_WDN] + (size_t)l * DFF * DM, DM, DFF, nb * 32, (bf16_t*)(F.ws + WS_WDN), nb * 32, kb * 64, scr, F.lane); }
    }
}
__device__ __forceinline__ void p1_fold(const Ctx& F, int l, int cs, int gs) {
    LAS float* Wl = (LAS float*)F.lds;
    LAS float* T128 = (LAS float*)(F.lds + 64 * 129 * 4);
    const float* T = (const float*)(F.ws + WS_T4096);
    const float* win = F.in[I_WIN] + (size_t)l * DM * PIN;
    bf16_t* WPT = (bf16_t*)(F.ws + WS_WPT);
    for (int item = cs; item < 256; item += gs) {
        const int g = item >> 6, kb = (item >> 2) & 15, qt = item & 3;
        __syncthreads();
        for (int i = F.tid; i < 64 * 128; i += 512) { const int k = i >> 7, c = i & 127; Wl[k * 129 + c] = win[(size_t)(kb * 64 + k) * PIN + 3104 + g * 128 + c]; }
        if (F.tid < 128) T128[F.tid] = T[F.tid * 32] * 0.08838834764831845f;
        __syncthreads();
        const int k = F.lane;
        for (int mi = 0; mi < 8; ++mi) {
            const int q = qt * 64 + F.wave * 8 + mi, s = q >> 7, m = q & 127;
            float a = 0.f;
#pragma unroll 8
            for (int c = 0; c < 128; ++c) a += Wl[k * 129 + c] * T128[(c * m + s * 96) & 127];
            const unsigned short b = (unsigned short)(cvt_pk_bf16(a, 0.f) & 0xffffu);
            WPT[(size_t)(s * 512 + g * 128 + m) * DM + kb * 64 + k] = b;
        }
    }
    __syncthreads();
}
__device__ __forceinline__ void p1_cgen(const Ctx& F, bool do256, int cs, int gs) {
    LAS float* T = (LAS float*)F.lds;
    const float* Tg = (const float*)(F.ws + WS_T4096);
    __syncthreads();
    for (int i = F.tid; i < 4096; i += 512) T[i] = Tg[i];
    __syncthreads();
    u32x4* C = (u32x4*)(F.ws + WS_C);
    const int nth = gs * 512;
    for (int it = cs * 512 + F.tid; it < 4096 * 512; it += nth) {
        const int n = it >> 9, kp = (it & 511) * 8, s = kp >> 11, k0 = kp & 2047;
        float v[8];
#pragma unroll
        for (int i = 0; i < 8; ++i) { const int k = k0 + i; const int idx = (s && k == 0) ? (n * 2048) : (n * k + s * 1024); v[i] = T[idx & 4095] * (1.0f / 64.0f); }
        u32x4 o; o.x = cvt_pk_bf16(v[0], v[1]); o.y = cvt_pk_bf16(v[2], v[3]); o.z = cvt_pk_bf16(v[4], v[5]); o.w = cvt_pk_bf16(v[6], v[7]);
        C[it] = o;
    }
    if (do256) {
        u32x4* C2 = (u32x4*)(F.ws + WS_C256);
        for (int it = cs * 512 + F.tid; it < 256 * 64; it += nth) {
            const int n = it >> 6, kp = (it & 63) * 8, s = kp >> 8, k0 = kp & 255;
            float v[8];
#pragma unroll
            for (int i = 0; i < 8; ++i) v[i] = T[((((n * (k0 + i)) & 255) << 4) + s * 1024) & 4095] * (1.0f / 16.0f);
            u32x4 o; o.x = cvt_pk_bf16(v[0], v[1]); o.y = cvt_pk_bf16(v[2], v[3]); o.z = cvt_pk_bf16(v[4], v[5]); o.w = cvt_pk_bf16(v[6], v[7]);
            C2[it] = o;
        }
    }
    __syncthreads();
}

struct FoldIn { u32x4 a, lo, s, slo; unsigned short hi, shi, mid; };
__device__ __forceinline__ void fold_load(const bf16_t* PTl, int it, FoldIn& I) {
    const int row = it >> 8, m = it & 255;
    const bf16_t* pc = PTl + (size_t)row * 8192; const bf16_t* ps = pc + 4096;
    I.a = *(const u32x4*)(pc + 8 * m); I.lo = *(const u32x4*)(pc + 8 * (511 - m)); I.s = *(const u32x4*)(ps + 8 * m); I.slo = *(const u32x4*)(ps + 8 * (511 - m));
    I.hi = pc[8 * (512 - m)]; I.shi = ps[8 * (512 - m) - (m == 0 ? 8 : 0)]; I.mid = pc[2048];
}
__device__ __forceinline__ void fold_finish(bf16_t* PT2, int it, const FoldIn& I) {
    const int row = it >> 8, m = it & 255;
    const u32x4 a = I.a, lo = I.lo, s = I.s, slo = I.slo;
    float av[8] = {bflo(a.x), bfhi(a.x), bflo(a.y), bfhi(a.y), bflo(a.z), bfhi(a.z), bflo(a.w), bfhi(a.w)};
    float sv[8] = {bflo(s.x), bfhi(s.x), bflo(s.y), bfhi(s.y), bflo(s.z), bfhi(s.z), bflo(s.w), bfhi(s.w)};
    const float lv[8] = {bflo(lo.x), bfhi(lo.x), bflo(lo.y), bfhi(lo.y), bflo(lo.z), bfhi(lo.z), bflo(lo.w), bfhi(lo.w)};
    const float tv[8] = {bflo(slo.x), bfhi(slo.x), bflo(slo.y), bfhi(slo.y), bflo(slo.z), bfhi(slo.z), bflo(slo.w), bfhi(slo.w)};
    av[0] += (m > 0) ? bf2f(I.hi) : 0.f; sv[0] -= (m > 0) ? bf2f(I.shi) : 0.f;
#pragma unroll
    for (int j = 1; j < 8; ++j) { av[j] += lv[8 - j]; sv[j] -= tv[8 - j]; }
    if (m == 0) sv[0] = bf2f(I.mid);
    u32x4 o1, o2;
    o1.x = cvt_pk_bf16(av[0], av[1]); o1.y = cvt_pk_bf16(av[2], av[3]); o1.z = cvt_pk_bf16(av[4], av[5]); o1.w = cvt_pk_bf16(av[6], av[7]);
    o2.x = cvt_pk_bf16(sv[0], sv[1]); o2.y = cvt_pk_bf16(sv[2], sv[3]); o2.z = cvt_pk_bf16(sv[4], sv[5]); o2.w = cvt_pk_bf16(sv[6], sv[7]);
    *(u32x4*)(PT2 + (size_t)row * 4096 + 8 * m) = o1; *(u32x4*)(PT2 + (size_t)row * 4096 + 2048 + 8 * m) = o2;
}
__device__ __forceinline__ void pt_fold(const Ctx& F) {
    const bf16_t* PTl = (const bf16_t*)(F.ws + WS_PT + 8 * MiB);
    bf16_t* PT2 = (bf16_t*)(F.ws + WS_PT2);
    const int nth = F.G * 512, NI = 2048 * 256;
    int it = F.bid * 512 + F.tid;
    for (; it + nth < NI; it += 2 * nth) {
        FoldIn A, B; fold_load(PTl, it, A); fold_load(PTl, it + nth, B);
        fold_finish(PT2, it, A); fold_finish(PT2, it + nth, B);
    }
    if (it < NI) { FoldIn A; fold_load(PTl, it, A); fold_finish(PT2, it, A); }
}
__device__ __forceinline__ void norm_pass(const Ctx& F, int mode, const float* nw, const float* mods_l, int shoff, int scoff, bool addp) {
    const int gw = F.bid * 8 + F.wave, NGW = F.G * 8;
    bf16_t* H = (bf16_t*)(F.ws + WS_H);
    f32x4 wv[4];
#pragma unroll
    for (int j = 0; j < 4; ++j) wv[j] = *(const f32x4*)(nw + 4 * F.lane + 256 * j);
    constexpr int NR = 5;
    for (int r0 = gw; r0 < MT; r0 += NR * NGW) {
        f32x4 v[NR][4]; float s[NR]; u32x4 pq[NR][4];
        const bf16_t* XP = (const bf16_t*)(F.ws + WS_XP);
#pragma unroll
        for (int q = 0; q < NR; ++q) s[q] = 0.f;
#pragma unroll
        for (int q = 0; q < NR; ++q) { const int r = r0 + q * NGW;
            if (r < MT) {
                const float* src = (mode == 0) ? (r < NCTX ? F.in[I_XP] + (size_t)r * DM : F.in[I_XS] + (size_t)(r - NCTX) * DM) : F.out + (size_t)r * DM;
#pragma unroll
                for (int j = 0; j < 4; ++j) v[q][j] = *(const f32x4*)(src + 4 * F.lane + 256 * j);
                if (addp && r < NCTX) {
#pragma unroll
                    for (int j = 0; j < 4; ++j) { const u32x2 a = *(const u32x2*)(XP + (size_t)r * DM + 4 * F.lane + 256 * j), b = *(const u32x2*)(XP + (size_t)(NCTX + r) * DM + 4 * F.lane + 256 * j); pq[q][j] = (u32x4){a.x, a.y, b.x, b.y}; }
                }
            } }
#pragma unroll
        for (int q = 0; q < NR; ++q) { const int r = r0 + q * NGW;
            if (r < MT) {
                if (addp && r < NCTX) {
#pragma unroll
                    for (int j = 0; j < 4; ++j) { const u32x4 p = pq[q][j];
                        v[q][j].x += bflo(p.x) + bflo(p.z); v[q][j].y += bfhi(p.x) + bfhi(p.z); v[q][j].z += bflo(p.y) + bflo(p.w); v[q][j].w += bfhi(p.y) + bfhi(p.w);
                        if (mode != 2) *(f32x4*)(F.out + (size_t)r * DM + 4 * F.lane + 256 * j) = v[q][j]; }
                }
#pragma unroll
                for (int j = 0; j < 4; ++j) s[q] += (v[q][j].x * v[q][j].x + v[q][j].y * v[q][j].y) + (v[q][j].z * v[q][j].z + v[q][j].w * v[q][j].w);
                const float rstd = rsqrtf(wave_sum(s[q]) * (1.0f / DM) + EPS);
                if (mode == 2) {
#pragma unroll
                    for (int j = 0; j < 4; ++j) { f32x4 o = v[q][j] * rstd * wv[j]; o[0] = fin_(o[0]); o[1] = fin_(o[1]); o[2] = fin_(o[2]); o[3] = fin_(o[3]); *(f32x4*)(F.out + (size_t)r * DM + 4 * F.lane + 256 * j) = o; }
                } else {
                    if (mode == 0) {
#pragma unroll
                        for (int j = 0; j < 4; ++j) *(f32x4*)(F.out + (size_t)r * DM + 4 * F.lane + 256 * j) = v[q][j];
                    }
                    const int cond = r < NCTX ? 0 : 1 + ((r - NCTX) >> 12);
                    const float* mp = mods_l + (size_t)cond * NMOD;
#pragma unroll
                    for (int j = 0; j < 4; ++j) {
                        const f32x4 sh = *(const f32x4*)(mp + shoff + 4 * F.lane + 256 * j), scv = *(const f32x4*)(mp + scoff + 4 * F.lane + 256 * j);
                        const f32x4 o = v[q][j] * rstd * wv[j] * (scv + 1.0f) + sh;
                        u32x2 w; w.x = cvt_pk_bf16(o[0], o[1]); w.y = cvt_pk_bf16(o[2], o[3]);
                        *(u32x2*)(H + (size_t)r * DM + 4 * F.lane + 256 * j) = w;
                    }
                }
            } }
    }
}

struct GkW { float wf[16], wb[16], bf, bb; };
__device__ __forceinline__ void gla_load_w(const Ctx& F, int l, int h, GkW& W) {
    const int d = F.lane;
    const float* wgf = F.in[I_WGKF] + (size_t)l * 16 * 256 + h * 64 + d; const float* wgb = F.in[I_WGKB] + (size_t)l * 16 * 256 + h * 64 + d;
#pragma unroll
    for (int r = 0; r < 16; ++r) { W.wf[r] = wgf[r * 256]; W.wb[r] = wgb[r * 256]; }
    W.bf = F.in[I_BGKF][l * 256 + h * 64 + d]; W.bb = F.in[I_BGKB][l * 256 + h * 64 + d];
}
__device__ __forceinline__ void gla_decay(const Ctx& F, const GkW& W, LAS float* gk, LAS float* seg, float (&bF)[8], float (&bB)[8], float& totF, float& totB) {
    const int d = F.lane, w = F.wave;
#pragma unroll
    for (int i = 0; i < 8; ++i) { bF[i] = W.bf; bB[i] = W.bb; }
#pragma unroll
    for (int r = 0; r < 16; ++r) {
        const float wf = W.wf[r], wb = W.wb[r];
        const f32x4 f0 = *(const LAS f32x4*)(gk + r * 64 + 8 * w), f1 = *(const LAS f32x4*)(gk + r * 64 + 8 * w + 4);
        const f32x4 g0 = *(const LAS f32x4*)(gk + (16 + r) * 64 + 8 * w), g1 = *(const LAS f32x4*)(gk + (16 + r) * 64 + 8 * w + 4);
#pragma unroll
        for (int j = 0; j < 4; ++j) { bF[j] += f0[j] * wf; bF[4 + j] += f1[j] * wf; bB[j] += g0[j] * wb; bB[4 + j] += g1[j] * wb; }
        if ((r & 3) == 3) asm volatile("" ::: "memory");
    }
#pragma unroll
    for (int i = 0; i < 8; ++i) { bF[i] = logsigf_(bF[i]) * (1.0f / 16.0f); bB[i] = logsigf_(bB[i]) * (1.0f / 16.0f); }
#pragma unroll
    for (int i = 1; i < 8; ++i) bF[i] += bF[i - 1];
#pragma unroll
    for (int i = 6; i >= 0; --i) bB[i] += bB[i + 1];
    seg[w * 64 + d] = bF[7]; seg[(8 + w) * 64 + d] = bB[0];
    __syncthreads();
    float offF = 0.f, offB = 0.f; totF = 0.f; totB = 0.f;
#pragma unroll
    for (int w2 = 0; w2 < 8; ++w2) { const float sf = seg[w2 * 64 + d], sb = seg[(8 + w2) * 64 + d]; totF += sf; totB += sb; if (w2 < w) offF += sf; if (w2 > w) offB += sb; }
#pragma unroll
    for (int i = 0; i < 8; ++i) { bF[i] += offF; bB[i] += offB; }
}
__device__ __forceinline__ void gla_stage_gk(const Ctx& F, int row0, LAS float* gk) {
    const bf16_t* GKT = (const bf16_t*)(F.ws + WS_GKT);
    const int idx = F.tid * 4, r = idx >> 6, t = idx & 63;
    const u32x2 w = *(const u32x2*)(GKT + (size_t)r * MT + row0 + t);
    gk[idx] = bflo(w.x); gk[idx + 1] = bfhi(w.x); gk[idx + 2] = bflo(w.y); gk[idx + 3] = bfhi(w.y);
}
__device__ __forceinline__ void gla_stage_vt(const Ctx& F, int row0, int h, LAS bf16_t* VT) {
    const bf16_t* Z1 = (const bf16_t*)(F.ws + WS_Z1);
#pragma unroll
    for (int rep = 0; rep < 2; ++rep) { const int e = F.tid & 127, ts = (F.tid >> 7) + 4 * rep;
        unsigned short v[8];
#pragma unroll
        for (int i = 0; i < 8; ++i) v[i] = Z1[(size_t)(row0 + 8 * ts + i) * NZA + 512 + h * 128 + e];
        u32x4 o; o.x = v[0] | ((unsigned)v[1] << 16); o.y = v[2] | ((unsigned)v[3] << 16); o.z = v[4] | ((unsigned)v[5] << 16); o.w = v[6] | ((unsigned)v[7] << 16);
        *(LAS u32x4*)(VT + e * 72 + 8 * ts) = o; }
}
__device__ __forceinline__ void gla_pass1(const Ctx& F, int l, int item, const GkW& W) {
    const int h = item & 3, ci = item >> 2, row0 = ci * 64, w = F.wave, d = F.lane;
    LAS float* gk = (LAS float*)F.lds; LAS float* seg = (LAS float*)(F.lds + 8192);
    LAS bf16_t* KoF = (LAS bf16_t*)(F.lds + 12288); LAS bf16_t* KoB = (LAS bf16_t*)(F.lds + 21504); LAS bf16_t* VT = (LAS bf16_t*)(F.lds + 30720);
    const bf16_t* Z1 = (const bf16_t*)(F.ws + WS_Z1);
    unsigned short kraw[8], vraw[2][8];
#pragma unroll
    for (int i = 0; i < 8; ++i) kraw[i] = Z1[(size_t)(row0 + 8 * w + i) * NZA + 256 + h * 64 + d];
#pragma unroll
    for (int rep = 0; rep < 2; ++rep) { const int e = F.tid & 127, ts = (F.tid >> 7) + 4 * rep;
#pragma unroll
        for (int i = 0; i < 8; ++i) vraw[rep][i] = Z1[(size_t)(row0 + 8 * ts + i) * NZA + 512 + h * 128 + e]; }
    __syncthreads();
    gla_stage_gk(F, row0, gk);
    __syncthreads();
    float bF[8], bB[8], totF, totB;
    gla_decay(F, W, gk, seg, bF, bB, totF, totB);
    {
        float kf[8], kb[8];
#pragma unroll
        for (int i = 0; i < 8; ++i) { const float kv = bf2f(kraw[i]); kf[i] = kv * __expf(totF - bF[i]); kb[i] = kv * __expf(totB - bB[i]); }
        u32x4 o; o.x = cvt_pk_bf16(kf[0], kf[1]); o.y = cvt_pk_bf16(kf[2], kf[3]); o.z = cvt_pk_bf16(kf[4], kf[5]); o.w = cvt_pk_bf16(kf[6], kf[7]);
        *(LAS u32x4*)(KoF + d * 72 + 8 * w) = o;
        o.x = cvt_pk_bf16(kb[0], kb[1]); o.y = cvt_pk_bf16(kb[2], kb[3]); o.z = cvt_pk_bf16(kb[4], kb[5]); o.w = cvt_pk_bf16(kb[6], kb[7]);
        *(LAS u32x4*)(KoB + d * 72 + 8 * w) = o;
    }
#pragma unroll
    for (int rep = 0; rep < 2; ++rep) { const int e = F.tid & 127, ts = (F.tid >> 7) + 4 * rep;
        u32x4 o; o.x = vraw[rep][0] | ((unsigned)vraw[rep][1] << 16); o.y = vraw[rep][2] | ((unsigned)vraw[rep][3] << 16); o.z = vraw[rep][4] | ((unsigned)vraw[rep][5] << 16); o.w = vraw[rep][6] | ((unsigned)vraw[rep][7] << 16);
        *(LAS u32x4*)(VT + e * 72 + 8 * ts) = o; }
    float* GG = (float*)(F.ws + WS_GG);
    if (w == 0) { GG[(size_t)((0 * NCH + ci) * 4 + h) * 64 + d] = __expf(totF); GG[(size_t)((1 * NCH + ci) * 4 + h) * 64 + d] = __expf(totB); }
    __syncthreads();
    const int r = F.lane & 15, quad = F.lane >> 4;
    bf16_t* US = (bf16_t*)(F.ws + WS_US);
#pragma unroll
    for (int dir = 0; dir < 2; ++dir) {
        const LAS bf16_t* Ko = dir ? KoB : KoF;
        bf16_t* ub = US + (size_t)((dir * NCH + ci) * 4 + h) * 8192;
        bf16x8 bv[2];
#pragma unroll
        for (int ks = 0; ks < 2; ++ks) bv[ks] = *(const LAS bf16x8*)(VT + (16 * w + r) * 72 + ks * 32 + quad * 8);
#pragma unroll
        for (int mt = 0; mt < 4; ++mt) {
            f32x4 acc = {0.f, 0.f, 0.f, 0.f};
#pragma unroll
            for (int ks = 0; ks < 2; ++ks) { const bf16x8 a = *(const LAS bf16x8*)(Ko + (16 * mt + r) * 72 + ks * 32 + quad * 8); acc = __builtin_amdgcn_mfma_f32_16x16x32_bf16(a, bv[ks], acc, 0, 0, 0); }
            u32x2 o; o.x = cvt_pk_bf16(acc[0], acc[1]); o.y = cvt_pk_bf16(acc[2], acc[3]);
            *(u32x2*)(ub + (16 * w + r) * 64 + 16 * mt + quad * 4) = o;
        }
    }
}
__device__ __forceinline__ void gla_scan(const Ctx& F, int l) {
    const bf16_t* US = (const bf16_t*)(F.ws + WS_US); bf16_t* SS = (bf16_t*)(F.ws + WS_SS); const float* GG = (const float*)(F.ws + WS_GG);
    float* ostate = F.out + (size_t)MT * DM;
    const int nth = F.G * 512;
    for (int wid = F.bid * 512 + F.tid; wid < 131072 + 524288; wid += nth) {
        const bool lat = wid < 131072; const int q = lat ? wid : wid - 131072;
        const int p = q & 4095, chain = q >> 12, dir = chain & 1, h = (chain >> 1) & 3, b = chain >> 3;
        const int e = p >> 5, d = (p & 31) * 2;
        const int N = lat ? 64 : 4, cbase = lat ? 64 + b * 64 : b * 4;
        const size_t sidx = ((size_t)((((b * 4 + l) * 2 + dir) * 4 + h) * 64 + d)) * 128 + e;
        float s0 = 0.f, s1 = 0.f;
        if (lat) { s0 = F.in[I_STATE][sidx]; s1 = F.in[I_STATE][sidx + 128]; }
#define SCAN_BATCH(NB) do { unsigned uu[NB]; f32x2 gg[NB]; \
            _Pragma("unroll") for (int i = 0; i < NB; ++i) { const int n = dir ? (N - 1 - (n0 + i)) : (n0 + i); const size_t cb = (size_t)((dir * NCH + cbase + n) * 4 + h); \
                uu[i] = *(const unsigned*)(US + cb * 8192 + e * 64 + d); gg[i] = *(const f32x2*)(GG + cb * 64 + d); } \
            _Pragma("unroll") for (int i = 0; i < NB; ++i) { const int n = dir ? (N - 1 - (n0 + i)) : (n0 + i); const size_t cb = (size_t)((dir * NCH + cbase + n) * 4 + h); \
                *(unsigned*)(SS + cb * 8192 + e * 64 + d) = cvt_pk_bf16(s0, s1); \
                s0 = gg[i].x * s0 + bflo(uu[i]); s1 = gg[i].y * s1 + bfhi(uu[i]); } } while (0)
        if (lat) { for (int n0 = 0; n0 < 64; n0 += 8) SCAN_BATCH(8); }
        else { const int n0 = 0; SCAN_BATCH(4); }
#undef SCAN_BATCH
        if (!lat) { ostate[sidx] = fin_(s0); ostate[sidx + 128] = fin_(s1); }
    }
}
__device__ __forceinline__ void gla_pass3(const Ctx& F, int l, int item, const GkW& W) {
    const int h = item & 3, ci = item >> 2, row0 = ci * 64, w = F.wave, d = F.lane;
    LAS float* gk = (LAS float*)F.lds; LAS float* seg = (LAS float*)(F.lds + 8192);
    LAS bf16_t* QF = (LAS bf16_t*)(F.lds + 12288); LAS bf16_t* QB = (LAS bf16_t*)(F.lds + 21504); LAS bf16_t* KF = (LAS bf16_t*)(F.lds + 30720); LAS bf16_t* KB = (LAS bf16_t*)(F.lds + 39936);
    LAS bf16_t* VT = (LAS bf16_t*)(F.lds + 49152); LAS bf16_t* PF = (LAS bf16_t*)(F.lds + 67584); LAS bf16_t* PB = (LAS bf16_t*)(F.lds + 76800); LAS float* O = (LAS float*)(F.lds + 86016);
    const bf16_t* Z1 = (const bf16_t*)(F.ws + WS_Z1);
    unsigned short qraw[8], kraw[8], vraw[2][8];
#pragma unroll
    for (int i = 0; i < 8; ++i) { const bf16_t* zr = Z1 + (size_t)(row0 + 8 * w + i) * NZA + h * 64 + d; qraw[i] = zr[0]; kraw[i] = zr[256]; }
#pragma unroll
    for (int rep = 0; rep < 2; ++rep) { const int e = F.tid & 127, ts = (F.tid >> 7) + 4 * rep;
#pragma unroll
        for (int i = 0; i < 8; ++i) vraw[rep][i] = Z1[(size_t)(row0 + 8 * ts + i) * NZA + 512 + h * 128 + e]; }
    const bf16_t* ogp = Z1 + (size_t)(row0 + (F.tid >> 3)) * NZA + 1024 + h * 128 + (F.tid & 7) * 16;
    const u32x4 og0 = *(const u32x4*)ogp, og1 = *(const u32x4*)(ogp + 8);
    bf16x8 sfr[2][2][4];
    {
        const bf16_t* SSg = (const bf16_t*)(F.ws + WS_SS);
        const int r_ = F.lane & 15, quad_ = F.lane >> 4, eh_ = w >> 2;
#pragma unroll
        for (int dir = 0; dir < 2; ++dir) { const bf16_t* Sb = SSg + (size_t)((dir * NCH + ci) * 4 + h) * 8192;
#pragma unroll
            for (int ks = 0; ks < 2; ++ks)
#pragma unroll
                for (int nt = 0; nt < 4; ++nt) sfr[dir][ks][nt] = *(const bf16x8*)(Sb + (16 * (eh_ * 4 + nt) + r_) * 64 + ks * 32 + quad_ * 8); }
    }
    __syncthreads();
    gla_stage_gk(F, row0, gk);
    __syncthreads();
    float bF[8], bB[8], totF, totB;
    gla_decay(F, W, gk, seg, bF, bB, totF, totB);
#pragma unroll
    for (int i = 0; i < 8; ++i) { const int t = 8 * w + i;
        const float qv = bf2f(qraw[i]) * 0.125f, kv = bf2f(kraw[i]); const float ef = __expf(bF[i]), eb = __expf(bB[i]);
        const unsigned a = cvt_pk_bf16(qv * ef, kv / ef), b2 = cvt_pk_bf16(qv * eb, kv / eb);
        QF[t * 72 + d] = (unsigned short)(a & 0xffffu); KF[t * 72 + d] = (unsigned short)(a >> 16); QB[t * 72 + d] = (unsigned short)(b2 & 0xffffu); KB[t * 72 + d] = (unsigned short)(b2 >> 16); }
#pragma unroll
    for (int rep = 0; rep < 2; ++rep) { const int e = F.tid & 127, ts = (F.tid >> 7) + 4 * rep;
        u32x4 o; o.x = vraw[rep][0] | ((unsigned)vraw[rep][1] << 16); o.y = vraw[rep][2] | ((unsigned)vraw[rep][3] << 16); o.z = vraw[rep][4] | ((unsigned)vraw[rep][5] << 16); o.w = vraw[rep][6] | ((unsigned)vraw[rep][7] << 16);
        *(LAS u32x4*)(VT + e * 72 + 8 * ts) = o; }
    __syncthreads();
    const int r = F.lane & 15, quad = F.lane >> 4;
    {
        const int dir = w >> 2, mt = w & 3; const LAS bf16_t* Q = dir ? QB : QF; const LAS bf16_t* Kk = dir ? KB : KF; LAS bf16_t* P = dir ? PB : PF;
        f32x4 acc[4];
#pragma unroll
        for (int nt = 0; nt < 4; ++nt) acc[nt] = (f32x4){0.f, 0.f, 0.f, 0.f};
#pragma unroll
        for (int ks = 0; ks < 2; ++ks) { const bf16x8 a = *(const LAS bf16x8*)(Q + (16 * mt + r) * 72 + ks * 32 + quad * 8);
#pragma unroll
            for (int nt = 0; nt < 4; ++nt) { const bf16x8 b = *(const LAS bf16x8*)(Kk + (16 * nt + r) * 72 + ks * 32 + quad * 8); acc[nt] = __builtin_amdgcn_mfma_f32_16x16x32_bf16(a, b, acc[nt], 0, 0, 0); } }
#pragma unroll
        for (int nt = 0; nt < 4; ++nt)
#pragma unroll
            for (int j = 0; j < 4; ++j) { const int t = 16 * mt + quad * 4 + j, s = 16 * nt + r; const bool keep = dir ? (s >= t) : (s <= t);
                P[t * 72 + s] = (unsigned short)(cvt_pk_bf16(keep ? acc[nt][j] : 0.f, 0.f) & 0xffffu); }
    }
    __syncthreads();
    {
        const int mt = w & 3, eh = w >> 2;
        const bf16_t* US = (const bf16_t*)(F.ws + WS_SS);
        f32x4 acc[4];
#pragma unroll
        for (int nt = 0; nt < 4; ++nt) acc[nt] = (f32x4){0.f, 0.f, 0.f, 0.f};
#pragma unroll
        for (int dir = 0; dir < 2; ++dir) {
            const LAS bf16_t* P = dir ? PB : PF; const LAS bf16_t* Q = dir ? QB : QF;
            const bf16_t* Sb = US + (size_t)((dir * NCH + ci) * 4 + h) * 8192;
#pragma unroll
            for (int ks = 0; ks < 2; ++ks) {
                const bf16x8 aP = *(const LAS bf16x8*)(P + (16 * mt + r) * 72 + ks * 32 + quad * 8);
                const bf16x8 aQ = *(const LAS bf16x8*)(Q + (16 * mt + r) * 72 + ks * 32 + quad * 8);
#pragma unroll
                for (int nt = 0; nt < 4; ++nt) { const int e = 16 * (eh * 4 + nt) + r;
                    const bf16x8 bV = *(const LAS bf16x8*)(VT + e * 72 + ks * 32 + quad * 8);
                    const bf16x8 bS = sfr[dir][ks][nt];
                    acc[nt] = __builtin_amdgcn_mfma_f32_16x16x32_bf16(aP, bV, acc[nt], 0, 0, 0);
                    acc[nt] = __builtin_amdgcn_mfma_f32_16x16x32_bf16(aQ, bS, acc[nt], 0, 0, 0); }
            }
        }
#pragma unroll
        for (int nt = 0; nt < 4; ++nt)
#pragma unroll
            for (int j = 0; j < 4; ++j) O[(16 * mt + quad * 4 + j) * 132 + 16 * (eh * 4 + nt) + r] = acc[nt][j];
    }
    __syncthreads();
    {
        const int t = F.tid >> 3, es = F.tid & 7;
        float v[16]; float ss = 0.f;
#pragma unroll
        for (int i = 0; i < 16; ++i) { v[i] = O[t * 132 + es * 16 + i]; ss += v[i] * v[i]; }
        ss += __shfl_xor(ss, 1); ss += __shfl_xor(ss, 2); ss += __shfl_xor(ss, 4);
        const float rstd = rsqrtf(ss * (1.0f / 128.0f) + EPS);
        const float* gn = F.in[I_GLAN] + l * 128 + es * 16;
        const u32x4 g0 = og0, g1 = og1;
        const unsigned gw[8] = {g0.x, g0.y, g0.z, g0.w, g1.x, g1.y, g1.z, g1.w};
        unsigned ow[8];
#pragma unroll
        for (int i = 0; i < 8; ++i) { const float a = v[2 * i] * rstd * gn[2 * i] * siluf_(bflo(gw[i])), b = v[2 * i + 1] * rstd * gn[2 * i + 1] * siluf_(bfhi(gw[i])); ow[i] = cvt_pk_bf16(a, b); }
        bf16_t* dst = (bf16_t*)(F.ws + WS_R4) + (size_t)(row0 + t) * 512 + h * 128 + es * 16;
        *(u32x4*)dst = (u32x4){ow[0], ow[1], ow[2], ow[3]}; *(u32x4*)(dst + 8) = (u32x4){ow[4], ow[5], ow[6], ow[7]};
    }
}
__device__ __forceinline__ void conv_pass(const Ctx& F, int l, int c_sub, int g_sub) {
    const bf16_t* Z1 = (const bf16_t*)(F.ws + WS_Z1B);
    bf16_t* ubuf = (bf16_t*)(F.ws + WS_R4) + (size_t)MT * 512;
    const float* cw = F.in[I_CONVW] + (size_t)l * 3 * 512;
    const int nth = g_sub * 512;
    for (int idx = c_sub * 512 + F.tid; idx < MT * 64; idx += nth) {
        const int row = idx >> 6, c0 = (idx & 63) * 8;
        const int Lm = row < NCTX ? 256 : 64, pos = row & (Lm - 1);
        const bf16_t* zr = Z1 + (size_t)row * NZA + c0;
        const u32x4 sb = *(const u32x4*)(zr);
        const u32x4 z0 = {0u, 0u, 0u, 0u};
        const u32x4 c1 = *(const u32x4*)(zr + 512), x1 = *(const u32x4*)(zr + 1024);
        const u32x4 cm = pos != 0 ? *(const u32x4*)(zr - NZA + 512) : z0, xm = pos != 0 ? *(const u32x4*)(zr - NZA + 1024) : z0;
        const u32x4 cp = pos != Lm - 1 ? *(const u32x4*)(zr + NZA + 512) : z0, xp = pos != Lm - 1 ? *(const u32x4*)(zr + NZA + 1024) : z0;
        const f32x4 w0a = *(const f32x4*)(cw + c0), w0b = *(const f32x4*)(cw + c0 + 4), w1a = *(const f32x4*)(cw + 512 + c0), w1b = *(const f32x4*)(cw + 512 + c0 + 4), w2a = *(const f32x4*)(cw + 1024 + c0), w2b = *(const f32x4*)(cw + 1024 + c0 + 4);
        unsigned ow[4];
#pragma unroll
        for (int i = 0; i < 4; ++i) {
            const float wl0 = i < 2 ? w0a[2 * i] : w0b[2 * i - 4], wh0 = i < 2 ? w0a[2 * i + 1] : w0b[2 * i - 3];
            const float wl1 = i < 2 ? w1a[2 * i] : w1b[2 * i - 4], wh1 = i < 2 ? w1a[2 * i + 1] : w1b[2 * i - 3];
            const float wl2 = i < 2 ? w2a[2 * i] : w2b[2 * i - 4], wh2 = i < 2 ? w2a[2 * i + 1] : w2b[2 * i - 3];
            const float lo = bflo(sb[i]) * (wl0 * bflo(cm[i]) * bflo(xm[i]) + wl1 * bflo(c1[i]) * bflo(x1[i]) + wl2 * bflo(cp[i]) * bflo(xp[i]));
            const float hi = bfhi(sb[i]) * (wh0 * bfhi(cm[i]) * bfhi(xm[i]) + wh1 * bfhi(c1[i]) * bfhi(x1[i]) + wh2 * bfhi(cp[i]) * bfhi(xp[i]));
            ow[i] = cvt_pk_bf16(lo, hi);
        }
        *(u32x4*)(ubuf + (size_t)row * 512 + c0) = (u32x4){ow[0], ow[1], ow[2], ow[3]};
    }
}


#define XB_TMO      128
#define XB_XCNT(j)  (256  + 64 * (j))
#define XB_XSUB(j)  (1280 + 64 * (j))
#define XB_XGEN(j)  (2304 + 64 * (j))
#define XB_TOP      3328
#define XB_TOPGEN   3392
#define XCD_BAR_WORDS 3456
#define XB_SPIN_CAP (1u << 18)
__device__ __forceinline__ unsigned xb_ld(unsigned* p)              { return __hip_atomic_load(p, __ATOMIC_RELAXED, __HIP_MEMORY_SCOPE_AGENT); }
__device__ __forceinline__ unsigned xb_add(unsigned* p, unsigned v) { return __hip_atomic_fetch_add(p, v, __ATOMIC_RELAXED, __HIP_MEMORY_SCOPE_AGENT); }
__device__ __forceinline__ unsigned xb_xcc_id() { return (unsigned)__builtin_amdgcn_s_getreg((3 << 11) | 20) & 0xFu; }
#define XB_SPIN(cond, bar) do { unsigned _sp = 0; while (cond) { __builtin_amdgcn_s_sleep(1); \
    if ((++_sp & 255u) == 0u) { if (xb_ld(&(bar)[XB_TMO])) break; if (_sp > XB_SPIN_CAP) { atomicAdd(&(bar)[XB_TMO], 1u); break; } } } } while (0)
struct XcdBarrier { unsigned* bar; unsigned x; volatile LAS unsigned* st; };
__device__ __forceinline__ void xcd_barrier_complete(unsigned* bar, unsigned x, unsigned& nloc, unsigned& nx) {
    const unsigned G = gridDim.x * gridDim.y * gridDim.z;
    unsigned sum, cnt, mine, sp = 0u;
    for (;;) {
        sum = 0u; cnt = 0u; mine = 0u;
#pragma unroll
        for (unsigned j = 0; j < 16; ++j) { const unsigned c = xb_ld(&bar[XB_XCNT(j)]); sum += c; cnt += (c > 0u) ? 1u : 0u; mine = (j == x) ? c : mine; }
        if (sum == G) break;
        __builtin_amdgcn_s_sleep(1);
        if ((++sp & 255u) == 0u) { if (xb_ld(&bar[XB_TMO])) break; if (sp > XB_SPIN_CAP) { atomicAdd(&bar[XB_TMO], 1u); break; } }
    }
    nloc = mine > 0u ? mine : 1u; nx = cnt > 0u ? cnt : 1u;
}
__device__ __forceinline__ void xcd_barrier(const XcdBarrier& b) {
    asm volatile("s_waitcnt vmcnt(0)" ::: "memory");
    __syncthreads();
    if (threadIdx.x == 0) {
        unsigned* bar = b.bar;
        __builtin_amdgcn_s_waitcnt(0);
        unsigned nloc = b.st[0], nx = b.st[1];
        if (nloc == 0u) { xcd_barrier_complete(bar, b.x, nloc, nx); b.st[0] = nloc; b.st[1] = nx; }
        const unsigned old = xb_add(&bar[XB_XSUB(b.x)], 1u);
        const unsigned gen = old / nloc;
        if (old + 1u == (gen + 1u) * nloc) {
            __builtin_amdgcn_fence(__ATOMIC_RELEASE, "agent");
            asm volatile("s_waitcnt vmcnt(0)" ::: "memory");
            const unsigned og = xb_add(&bar[XB_TOP], 1u);
            const unsigned tg = og / nx;
            if (og + 1u == (tg + 1u) * nx) xb_add(&bar[XB_TOPGEN], 1u);
            else XB_SPIN(xb_ld(&bar[XB_TOPGEN]) == tg, bar);
            __builtin_amdgcn_fence(__ATOMIC_ACQUIRE, "agent");
            xb_add(&bar[XB_XGEN(b.x)], 1u);
            asm volatile("s_waitcnt vmcnt(0)" ::: "memory");
        } else {
            XB_SPIN(xb_ld(&bar[XB_XGEN(b.x)]) == gen, bar);
            __builtin_amdgcn_fence(__ATOMIC_ACQUIRE, "agent");
            asm volatile("s_waitcnt vmcnt(0)" ::: "memory");
        }
    }
    __syncthreads();
}
#define CG_SYNC() do { asm volatile("s_waitcnt vmcnt(0) lgkmcnt(0)" ::: "memory"); __syncthreads(); \
    grid.sync(); __builtin_amdgcn_fence(__ATOMIC_ACQUIRE, "agent"); asm volatile("s_waitcnt vmcnt(0)" ::: "memory"); } while (0)
#define GRID_SYNC() do { XcdBarrier _b; _b.bar = (unsigned*)(F.ws + WS_BAR); _b.x = xb_xcc_id(); _b.st = (volatile LAS unsigned*)(F.lds + LDS_MISC); xcd_barrier(_b); } while (0)
#define LAYER_BODY() do { \
        REFRESH(); \
        if (l == 0 || !early) { \
            if (PH(1)) REP(1) p1_convert(F, l, 0, F.bid, F.G); \
            if (PH(2)) REP(2) p1_fold(F, l, F.bid, F.G); \
            if (PH(3)) REP(3) p1_cgen(F, l == 0, F.bid, F.G); \
        } else { \
            if (PH(1)) p1_convert(F, l, 0, F.bid, F.G); \
        } \
        if (PH(4)) REP(4) norm_pass(F, l == 0 ? 0 : 1, F.in[I_N1] + l * DM, mods_l, 0, DM, l != 0); \
        GRID_SYNC(); REFRESH(); \
        if (PH(6)) REP(6) { \
            pg8::Gemm g{(const bf16_t*)(ws + WS_WPT), H, NPT, MT, DM}; pg8::StaticOrder S; S.init(NPT, MT, F.G, F.bid); \
            pg8::EpiPT E{(bf16_t*)(ws + WS_PT), (bf16_t*)(ws + WS_PT + 8 * MiB), (bf16_t*)(ws + WS_GKT)}; \
            pg8::gemm_phase<pg8::EpiPT, pg8::StaticOrder, true, true>(F.lds, g, S, E); \
        } \
        if (PH(5)) REP(5) { \
            pg8::Gemm g{H, (const bf16_t*)(ws + WS_WIN), MT, NZ1, DM}; pg8::StaticOrder S; S.init(MT, NZ1, F.G, F.bid); \
            pg8::EpiBf16<0> E{Z1, NZA, 2, 0, 0}; \
            pg8::gemm_phase<pg8::EpiBf16<0>, pg8::StaticOrder, true, true>(F.lds, g, S, E); \
        } \
        GRID_SYNC(); REFRESH(); \
        if (PH(21)) pt_fold(F); \
        GRID_SYNC(); REFRESH(); \
        if (F.bid < half) { \
            if (PH(7)) REP(7) { \
            pg8::Gemm g{(const bf16_t*)(ws + WS_C), (const bf16_t*)(ws + WS_PT2), 4096, 2048, 4096}; pg8::StaticOrder S; S.init(4096, 2048, half, F.bid); \
            pg8::EpiBf16<0> E{(bf16_t*)(ws + WS_R4) + (size_t)2 * MT * 512, 512, 1, NCTX, 4096}; \
            pg8::gemm_phase<pg8::EpiBf16<0>, pg8::StaticOrder, true, true>(F.lds, g, S, E); \
            } \
        } else { \
            const int cs = F.bid - half, gs = F.G - half; \
            if (PH(8)) REP(8) { \
                pg8::Gemm g{(const bf16_t*)(ws + WS_C256), (const bf16_t*)(ws + WS_PT), 256, 8192, 512}; pg8::StaticOrder S; S.init(256, 8192, gs, cs); \
                pg8::EpiBf16<0> E{(bf16_t*)(ws + WS_R4) + (size_t)2 * MT * 512, 512, 1, 0, 256}; \
                pg8::gemm_phase<pg8::EpiBf16<0>, pg8::StaticOrder, true, true>(F.lds, g, S, E); \
            } \
            if (PH(9)) REP(9) { GkW W; int hW = -1; for (int it = cs; it < NCH * 4; it += gs) { if ((it & 3) != hW) { hW = it & 3; gla_load_w(F, l, hW, W); } gla_pass1(F, l, it, W); } } \
        } \
        if (PH(10)) REP(10) conv_pass(F, l, F.bid, F.G); \
        GRID_SYNC(); REFRESH(); \
        if (PH(11)) REP(11) gla_scan(F, l); \
        GRID_SYNC(); REFRESH(); \
        if (PH(13)) REP(13) { \
            pg8::Gemm g{H, (const bf16_t*)(ws + WS_WMG), MT, NMG, DM}; pg8::StaticOrder S; S.init(MT, NMG, F.G, F.bid); \
            pg8::EpiBf16<2> E{(bf16_t*)(ws + WS_ZG), NMG, 0, 0, 0}; \
            pg8::gemm_phase<pg8::EpiBf16<2>, pg8::StaticOrder, true, true>(F.lds, g, S, E); \
        } \
        __syncthreads(); \
        if (PH(12)) REP(12) { GkW W; int hW = -1; for (int it = F.bid; it < NCH * 4; it += F.G) { if ((it & 3) != hW) { hW = it & 3; gla_load_w(F, l, hW, W); } gla_pass3(F, l, it, W); } } \
        GRID_SYNC(); REFRESH(); \
        if (PH(14)) REP(14) { \
            pg8::Gemm g{(const bf16_t*)(ws + WS_R4), (const bf16_t*)(ws + WS_WABC), 3 * MT, 3 * DM, 512}; pg8::BranchOrder S; S.init(F.G, F.bid); \
            pg8::EpiBranch E{(const bf16_t*)(ws + WS_ZG), (float*)(ws + WS_Z1), (bf16_t*)(ws + WS_YBF)}; \
            pg8::gemm_phase<pg8::EpiBranch, pg8::BranchOrder, true, true>(F.lds, g, S, E); \
        } \
        GRID_SYNC(); REFRESH(); \
        if (PH(15)) REP(15) { \
            pg8::Gemm g{(const bf16_t*)(ws + WS_YBF), (const bf16_t*)(ws + WS_WO), MT, DM, DM}; pg8::StaticOrder S; S.init(MT, DM, F.G, F.bid); \
            pg8::EpiRes E{F.out, mods_l + 2 * DM, RSC}; \
            pg8::gemm_phase<pg8::EpiRes, pg8::StaticOrder, true, true>(F.lds, g, S, E); \
        } \
        if (early && l < DEPTH - 1 && F.bid >= 64) { __syncthreads(); p1_cgen(F, false, F.bid - 64, F.G - 64); } \
        GRID_SYNC(); REFRESH(); \
        if (PH(16)) REP(16) norm_pass(F, 1, F.in[I_N2] + l * DM, mods_l, 3 * DM, 4 * DM, false); \
        GRID_SYNC(); REFRESH(); \
        if (PH(17)) REP(17) { \
            pg8::Gemm g{H, (const bf16_t*)(ws + WS_WUP), MT, 2 * DFF, DM}; pg8::StaticOrder S; S.init(MT, 2 * DFF, F.G, F.bid); \
            pg8::EpiSwiglu E{Z1}; \
            pg8::gemm_phase<pg8::EpiSwiglu, pg8::StaticOrder, true, true>(F.lds, g, S, E); \
        } \
        GRID_SYNC(); REFRESH(); \
        if (PH(18)) { \
            { pg8::Gemm g{Z1, (const bf16_t*)(ws + WS_WDN), MT, DM, DFF, 0}; pg8::LatOrder S; S.init(F.G, F.bid); \
              pg8::EpiRes E{F.out, mods_l + 5 * DM, RSC}; \
              pg8::gemm_phase<pg8::EpiRes, pg8::LatOrder, true, true>(F.lds, g, S, E); } \
            { pg8::Gemm g{Z1, (const bf16_t*)(ws + WS_WDN), MT, DM, DFF, DFF / 2}; pg8::CtxSplitOrder S; S.init(F.G, F.bid, DFF / 2); \
              pg8::EpiPart E{(bf16_t*)(ws + WS_XP), mods_l + 5 * DM}; \
              pg8::gemm_phase<pg8::EpiPart, pg8::CtxSplitOrder, true, true>(F.lds, g, S, E); } \
        } \
        if (early && l < DEPTH - 1 && F.bid < 128) { __syncthreads(); p1_fold(F, l + 1, F.bid, 128); } \
        GRID_SYNC(); REFRESH(); \
     \
    } while (0)
__global__ void __launch_bounds__(512, 2) fwd_megakernel(Args args) {
    extern __shared__ __attribute__((aligned(16))) unsigned char lds_raw[];
    cg::grid_group grid = cg::this_grid();
    Ctx F;
    F.lds = (LAS unsigned char*)lds_raw;
    F.tid = threadIdx.x; F.lane = F.tid & 63; F.wave = __builtin_amdgcn_readfirstlane(F.tid >> 6);
    F.G = gridDim.x; F.bid = blockIdx.x;
    unsigned char* ws; const float* mods; const float* mods_l; bf16_t* H; bf16_t* Z1; int l = 0;
    REFRESH();
    const int half = F.G >> 1;
    const bool early = F.G > 128;

#ifndef PHMASK
#define PHMASK 0xFFFFFF
#endif
#define PH(k) ((PHMASK >> (k)) & 1)
#ifndef RPMASK
#define RPMASK 0
#endif
#define RSC 1.0f
#define REP(k) for (int _rp = 0; _rp < 1 + ((RPMASK >> (k)) & 1); ++_rp)
    if (F.tid < 64) ((LAS unsigned*)(F.lds + 131072))[F.tid] = 0u;
    __syncthreads();
    if (F.tid == 0) (void)xb_add(&((unsigned*)(F.ws + WS_BAR))[XB_XCNT(xb_xcc_id())], 1u);
    if (PH(0)) p0_mods(F);
    CG_SYNC();

    l = 0; LAYER_BODY();
    l = 1; LAYER_BODY();
    l = 2; LAYER_BODY();
    l = 3; LAYER_BODY();
    l = 0; REFRESH();
    if (!PH(11)) { float* os = F.out + (size_t)MT * DM; for (int i = F.bid * 512 + F.tid; i < 4194304; i += F.G * 512) os[i] = 0.f; }
    if (PH(19)) norm_pass(F, 2, F.in[I_NF], mods, 0, 0, true);
}

extern "C" void kernel_launch(void* const* d_in, const int* in_sizes, int n_in, void* d_out, int out_size, void* d_ws, size_t ws_size, hipStream_t stream) {
    static int grid = 0;
    if (grid == 0) {
        if (n_in != 23 || ws_size < WS_END) { fprintf(stderr, "kernel_launch: unexpected n_in %d / ws_size %zu (need %zu)\n", n_in, ws_size, (size_t)WS_END); grid = -1; return; }
        int dev = 0, cus = 0, per_cu = 0;
        hipGetDevice(&dev);
        hipDeviceGetAttribute(&cus, hipDeviceAttributeMultiprocessorCount, dev);
        hipFuncSetAttribute((const void*)fwd_megakernel, hipFuncAttributeMaxDynamicSharedMemorySize, LDS_BYTES);
        hipOccupancyMaxActiveBlocksPerMultiprocessor(&per_cu, (const void*)fwd_megakernel, 512, LDS_BYTES);
        (void)hipGetLastError();
        if (per_cu < 1) per_cu = 1;
        grid = cus;
    }
    if (grid < 0) return;
    (void)hipMemsetAsync((char*)d_ws + WS_BAR, 0, 16384, stream);
    Args a{};
    for (int i = 0; i < 23; ++i) a.in[i] = (const float*)d_in[i];
    a.out = (float*)d_out; a.ws = (unsigned char*)d_ws;
    void* params[] = {&a};
    hipError_t e = hipLaunchCooperativeKernel((const void*)fwd_megakernel, dim3(grid), dim3(512), params, LDS_BYTES, stream);
    if (e != hipSuccess) fprintf(stderr, "cooperative launch failed: %s (grid %d)\n", hipGetErrorString(e), grid);
}
```
